# Optimizing an MI355X kernel written in HIP

```python
import jax, jax.numpy as jnp
from jax import lax
import numpy as np

D_MODEL = 1024
BATCH = 8
SEQ = 4096
DEPTH = 4

D_MIX = D_MODEL
D_LRU = D_MIX // 2
D_ATTN = D_MIX - D_LRU
LRU_BLOCKS = 8
LRU_BLOCK_DIM = D_LRU // LRU_BLOCKS
CONV_WIDTH = 4
LRU_C = 8.0
HEAD_DIM = 64
N_HEADS = D_ATTN // HEAD_DIM
DILATED_CONFIGS = ((128, 1), (512, 4), (2048, 16))
ATTN_BLOCK = 128
D_IN = 2 * D_LRU + 3 * D_ATTN
N_GROUPS = 4
EXPERTS_PER_GROUP = 8
N_EXPERTS = N_GROUPS * EXPERTS_PER_GROUP
TOP_K = 2
D_EXPERT = D_MODEL // 2
MOE_BLOCK = 128
EPS = 1e-6

kernel_name = "hymba_style_rglru_dilated_attn_hmoe"


def rms_norm(x, g):
    xf = x.astype(jnp.float32)
    y = xf * lax.rsqrt(jnp.mean(xf * xf, axis=-1, keepdims=True) + EPS)
    return (y * g.astype(jnp.float32)).astype(x.dtype)


def causal_depthwise_conv(x, w, b):
    k_width = w.shape[0]
    s_len = x.shape[1]
    xp = jnp.pad(x, ((0, 0), (k_width - 1, 0), (0, 0)))
    out = b
    for j in range(k_width):
        out = out + w[j] * xp[:, j:j + s_len]
    return out


def _lin_rec_combine(c1, c2):
    a1, b1 = c1
    a2, b2 = c2
    return a1 * a2, a2 * b1 + b2


def rg_lru(x, w_a, b_a, w_x, b_x, lam):
    xh = x.reshape(x.shape[0], x.shape[1], LRU_BLOCKS, LRU_BLOCK_DIM)
    r = jax.nn.sigmoid(jnp.einsum('bshi,hij->bshj', xh, w_a).reshape(x.shape) + b_a)
    i = jax.nn.sigmoid(jnp.einsum('bshi,hij->bshj', xh, w_x).reshape(x.shape) + b_x)
    log_a = -LRU_C * r * jax.nn.softplus(-lam)
    a = jnp.exp(log_a)
    u = jnp.sqrt(-jnp.expm1(2.0 * log_a)) * (i * x)
    _, h = lax.associative_scan(_lin_rec_combine, (a, u), axis=1)
    return h


def _dilated_branch(q, k, v, window, dilation):
    b, h, sp, dh = q.shape
    steps = window // dilation
    n_sub = sp // dilation
    nb = n_sub // ATTN_BLOCK

    def to_blocks(t):
        t = t.reshape(b, h, n_sub, dilation, dh).transpose(0, 1, 3, 2, 4)
        return t.reshape(b, h, dilation, nb, ATTN_BLOCK, dh)

    def with_prev(t):
        prev = jnp.pad(t, ((0, 0), (0, 0), (0, 0), (1, 0), (0, 0), (0, 0)))[:, :, :, :-1]
        return jnp.concatenate([prev, t], axis=4)

    qb = to_blocks(q)
    kc = with_prev(to_blocks(k))
    vc = with_prev(to_blocks(v))
    s = jnp.einsum('bhrnqd,bhrnkd->bhrnqk', qb, kc) * (HEAD_DIM ** -0.5)
    qi = jnp.arange(ATTN_BLOCK)[:, None]
    kj = jnp.arange(2 * ATTN_BLOCK)[None, :]
    dist = ATTN_BLOCK + qi - kj
    band = (dist >= 0) & (dist <= steps)
    first = (jnp.arange(nb) == 0)[:, None, None]
    valid = band[None] & ~(first & (kj < ATTN_BLOCK)[None])
    s = jnp.where(valid, s, -jnp.inf)
    m = jnp.max(s, axis=-1, keepdims=True)
    p = jnp.exp(s - m)
    denom = jnp.sum(p, axis=-1, keepdims=True)
    o = jnp.einsum('bhrnqk,bhrnkd->bhrnqd', p, vc) / denom
    lse = (m + jnp.log(denom))[..., 0]
    o = o.reshape(b, h, dilation, n_sub, dh).transpose(0, 1, 3, 2, 4).reshape(b, h, sp, dh)
    lse = lse.reshape(b, h, dilation, n_sub).transpose(0, 1, 3, 2).reshape(b, h, sp)
    return o, lse


def dilated_attention(q, k, v):
    s_len = q.shape[1]
    seg = ATTN_BLOCK * max(d for _, d in DILATED_CONFIGS)
    sp = -(-s_len // seg) * seg

    def prep(t):
        t = t.astype(jnp.float32).transpose(0, 2, 1, 3)
        return jnp.pad(t, ((0, 0), (0, 0), (0, sp - s_len), (0, 0)))

    qp, kp, vp = prep(q), prep(k), prep(v)
    outs = []
    lses = []
    for window, dilation in DILATED_CONFIGS:
        o, lse = _dilated_branch(qp, kp, vp, window, dilation)
        outs.append(o)
        lses.append(lse)
    wts = jax.nn.softmax(jnp.stack(lses, axis=0), axis=0)
    o = jnp.sum(jnp.stack(outs, axis=0) * wts[..., None], axis=0)
    return o[:, :, :s_len].transpose(0, 2, 1, 3)


def hierarchical_moe(h2, wg, bg, we, be, w_gate, w_up, w_down):
    n_tok, d = h2.shape
    hf = h2.astype(jnp.float32)
    group_prob = jax.nn.softmax(hf @ wg.astype(jnp.float32) + bg.astype(jnp.float32), axis=-1)
    p_top, g_idx = lax.top_k(group_prob, 1)
    expert_logits = (hf @ we.astype(jnp.float32) + be.astype(jnp.float32)).reshape(
        n_tok, N_GROUPS, EXPERTS_PER_GROUP)
    gi = jnp.broadcast_to(g_idx[:, :, None], (n_tok, 1, EXPERTS_PER_GROUP))
    local_logits = jnp.take_along_axis(expert_logits, gi, axis=1)[:, 0]
    top_vals, top_local = lax.top_k(local_logits, TOP_K)
    gate_w = jax.nn.softmax(top_vals, axis=-1) * p_top
    expert_idx = g_idx * EXPERTS_PER_GROUP + top_local

    n_asg = n_tok * TOP_K
    e_flat = expert_idx.reshape(n_asg)
    tok_flat = jnp.repeat(jnp.arange(n_tok, dtype=jnp.int32), TOP_K)
    g_flat = gate_w.reshape(n_asg)
    order = jnp.argsort(e_flat)
    e_s, tok_s, g_s = e_flat[order], tok_flat[order], g_flat[order]
    counts = jnp.bincount(e_flat, length=N_EXPERTS)
    padded = ((counts + MOE_BLOCK - 1) // MOE_BLOCK) * MOE_BLOCK
    start = jnp.cumsum(counts) - counts
    pend = jnp.cumsum(padded)
    pstart = pend - padded
    dest = pstart[e_s] + (jnp.arange(n_asg, dtype=jnp.int32) - start[e_s])
    n_rows = n_asg + N_EXPERTS * MOE_BLOCK
    n_blk = n_rows // MOE_BLOCK
    x_buf = jnp.zeros((n_rows, d), h2.dtype).at[dest].set(h2[tok_s])
    blk_expert = jnp.minimum(
        jnp.searchsorted(pend, jnp.arange(n_blk, dtype=jnp.int32) * MOE_BLOCK, side='right'),
        N_EXPERTS - 1)

    def expert_block(args):
        xb, e = args
        hid = jax.nn.silu(xb @ w_gate[e]) * (xb @ w_up[e])
        return hid @ w_down[e]

    y_buf = lax.map(expert_block, (x_buf.reshape(n_blk, MOE_BLOCK, d), blk_expert))
    y_buf = y_buf.reshape(n_rows, d)
    contrib = g_s[:, None].astype(y_buf.dtype) * y_buf[dest]
    return jnp.zeros((n_tok, d), h2.dtype).at[tok_s].add(contrib.astype(h2.dtype))


def setup_inputs(seed: int = 0) -> dict:
    key = jax.random.key(seed)
    ks = jax.random.split(key, 23)
    f32 = jnp.float32
    L = DEPTH

    def nrm(k, shape, scale):
        return jax.random.normal(k, shape, f32) * scale

    def gain(k, shape):
        return 1.0 + 0.05 * jax.random.normal(k, shape, f32)

    res_scale = (2.0 * DEPTH) ** -0.5
    u = jax.random.uniform(ks[9], (L, D_LRU), f32, 0.9, 0.999)
    a0 = u ** (1.0 / LRU_C)
    lam = jnp.log(a0) - jnp.log1p(-a0)
    return {
        "x": jax.random.normal(ks[0], (BATCH, SEQ, D_MODEL), f32),
        "norm_mix": gain(ks[1], (L, D_MODEL)),
        "w_in": nrm(ks[2], (L, D_MODEL, D_IN), D_MODEL ** -0.5),
        "conv_w": nrm(ks[3], (L, CONV_WIDTH, D_LRU), CONV_WIDTH ** -0.5),
        "conv_b": nrm(ks[4], (L, D_LRU), 0.02),
        "lru_w_a": nrm(ks[5], (L, LRU_BLOCKS, LRU_BLOCK_DIM, LRU_BLOCK_DIM), LRU_BLOCK_DIM ** -0.5),
        "lru_b_a": nrm(ks[6], (L, D_LRU), 0.02),
        "lru_w_x": nrm(ks[7], (L, LRU_BLOCKS, LRU_BLOCK_DIM, LRU_BLOCK_DIM), LRU_BLOCK_DIM ** -0.5),
        "lru_b_x": nrm(ks[8], (L, D_LRU), 0.02),
        "lru_lambda": lam,
        "q_norm": gain(ks[10], (L, HEAD_DIM)),
        "k_norm": gain(ks[11], (L, HEAD_DIM)),
        "norm_out_lru": gain(ks[12], (L, D_LRU)),
        "norm_out_attn": gain(ks[13], (L, D_ATTN)),
        "w_out": nrm(ks[14], (L, D_MIX, D_MODEL), D_MIX ** -0.5 * res_scale),
        "norm_ffn": gain(ks[15], (L, D_MODEL)),
        "router_group_w": nrm(ks[16], (L, D_MODEL, N_GROUPS), D_MODEL ** -0.5),
        "router_group_b": nrm(ks[17], (L, N_GROUPS), 0.01),
        "router_expert_w": nrm(ks[18], (L, D_MODEL, N_EXPERTS), D_MODEL ** -0.5),
        "router_expert_b": nrm(ks[19], (L, N_EXPERTS), 0.01),
        "w_gate": nrm(ks[20], (L, N_EXPERTS, D_MODEL, D_EXPERT), D_MODEL ** -0.5),
        "w_up": nrm(ks[21], (L, N_EXPERTS, D_MODEL, D_EXPERT), D_MODEL ** -0.5),
        "w_down": nrm(ks[22], (L, N_EXPERTS, D_EXPERT, D_MODEL), D_EXPERT ** -0.5 * res_scale),
    }


def reference(x, norm_mix, w_in, conv_w, conv_b, lru_w_a, lru_b_a, lru_w_x, lru_b_x,
              lru_lambda, q_norm, k_norm, norm_out_lru, norm_out_attn, w_out, norm_ffn,
              router_group_w, router_group_b, router_expert_w, router_expert_b,
              w_gate, w_up, w_down):
    b, s_len, d = x.shape
    o1 = D_LRU
    o2 = 2 * D_LRU
    o3 = o2 + D_ATTN
    o4 = o3 + D_ATTN
    for l in range(DEPTH):
        h = rms_norm(x, norm_mix[l])
        proj = jnp.einsum('bsd,de->bse', h, w_in[l])
        x_lru = proj[..., :o1]
        gate_lru = proj[..., o1:o2]
        q = proj[..., o2:o3].reshape(b, s_len, N_HEADS, HEAD_DIM)
        k = proj[..., o3:o4].reshape(b, s_len, N_HEADS, HEAD_DIM)
        v = proj[..., o4:].reshape(b, s_len, N_HEADS, HEAD_DIM)

        xc = causal_depthwise_conv(x_lru, conv_w[l], conv_b[l]).astype(jnp.float32)
        hl = rg_lru(xc, lru_w_a[l], lru_b_a[l], lru_w_x[l], lru_b_x[l], lru_lambda[l])
        y_lru = (hl * jax.nn.gelu(gate_lru.astype(jnp.float32))).astype(x.dtype)

        q = rms_norm(q, q_norm[l])
        k = rms_norm(k, k_norm[l])
        y_attn = dilated_attention(q, k, v).reshape(b, s_len, D_ATTN).astype(x.dtype)

        merged = jnp.concatenate(
            [rms_norm(y_lru, norm_out_lru[l]), rms_norm(y_attn, norm_out_attn[l])], axis=-1)
        x = x + jnp.einsum('bse,ed->bsd', merged, w_out[l])

        h2 = rms_norm(x, norm_ffn[l]).reshape(b * s_len, d)
        y = hierarchical_moe(h2, router_group_w[l], router_group_b[l], router_expert_w[l],
                             router_expert_b[l], w_gate[l], w_up[l], w_down[l])
        x = x + y.reshape(b, s_len, d)
    return x
```

```cpp
#include <hip/hip_runtime.h>
#include <cstdio>
#include <cstdint>
#include <cmath>

constexpr int NB = 8, SEQ = 4096, T = NB * SEQ, D = 1024, DEPTH = 4;
constexpr int DL = 512, DA = 512, NHEAD = 8, HD = 64, DIN = 2560;
constexpr int NE = 32, DE = 512, NGRP = 4, EPG = 8;
constexpr int NCHUNK = SEQ / 32;
constexpr int SLAB_ROWS = 2 * T + NE * 256;
constexpr float EPS = 1e-6f;
constexpr float QSCALE = 0.125f * 1.4426950408889634f;

typedef unsigned short bf16;
typedef short bf16x8 __attribute__((ext_vector_type(8)));
typedef float f32x4 __attribute__((ext_vector_type(4)));
typedef unsigned u32x4 __attribute__((ext_vector_type(4)));
typedef unsigned u32x2 __attribute__((ext_vector_type(2)));
#define LAS __attribute__((address_space(3)))

constexpr size_t MiB = 1u << 20;
constexpr size_t WS_CTL = 0, CTL_BYTES = 1 * MiB;
constexpr size_t WS_WIN = 1 * MiB;
constexpr size_t WS_WOUT = WS_WIN + 20 * MiB;
constexpr size_t WS_WGU = WS_WOUT + 8 * MiB;
constexpr size_t WS_WD = WS_WGU + 256 * MiB;
constexpr size_t WS_WR = WS_WD + 128 * MiB;
constexpr size_t WS_LRUW = WS_WR + 1 * MiB;
constexpr size_t WS_SP = WS_LRUW + 1 * MiB;
constexpr size_t WS_XB = WS_SP + 1 * MiB;
constexpr size_t WS_RSTD1 = WS_XB + 64 * MiB;
constexpr size_t WS_RSTD2 = WS_RSTD1 + 128 * 1024;
constexpr size_t WS_ASG = WS_RSTD2 + 128 * 1024;
constexpr size_t WS_LIST = WS_ASG + 1 * MiB;
constexpr size_t WS_ACT = WS_LIST + 4 * MiB;
constexpr size_t A_XL = 0, A_GG = 32 * MiB, A_Q = 64 * MiB, A_K = 96 * MiB, A_V = 128 * MiB;
constexpr size_t A_OBR = 160 * MiB;
constexpr size_t A_LBR = 256 * MiB;
constexpr size_t A_HL = 260 * MiB, A_PC = 292 * MiB;
constexpr size_t A_AGG = 324 * MiB;
constexpr size_t A_MERGED = A_Q;
constexpr size_t A_HID = 0;
constexpr size_t A_YS = 72 * MiB;
constexpr size_t ACT_BYTES = 332 * MiB;
constexpr size_t WS_TMP = WS_ACT + ACT_BYTES;
constexpr size_t WS_END = WS_TMP + 128 * MiB;
static_assert(WS_END <= 1024 * MiB, "workspace map must fit 1 GiB");
constexpr int CW_CNT = 64;

struct Params {
    const float* in[23];
    float* out;
    unsigned char* ws;
};

__device__ __forceinline__ unsigned f2bf(float f) { unsigned u = __builtin_bit_cast(unsigned, f); return (u + 0x7fffu + ((u >> 16) & 1u)) >> 16; }
__device__ __forceinline__ float bf2f(unsigned h) { return __builtin_bit_cast(float, h << 16); }
__device__ __forceinline__ unsigned pk2(float lo, float hi) { return f2bf(lo) | (f2bf(hi) << 16); }
__device__ __forceinline__ float wave_sum(float v) {
#pragma unroll
    for (int o = 1; o < 64; o <<= 1) v += __shfl_xor(v, o);
    return v;
}
__device__ __forceinline__ float gelu_tanh(float x) {
    const float z = 0.7978845608028654f * (x + 0.044715f * x * x * x);
    const float e = __expf(2.f * z);
    const float th = 1.f - 2.f / (1.f + e);
    return 0.5f * x * (1.f + th);
}
__device__ __forceinline__ float sigmoidf_(float x) { return 1.f / (1.f + __expf(-x)); }

__host__ __device__ __forceinline__ int win_row(int n) {
    if (n < 1024 || n >= 2048) return n;
    const int s = (n - 1024) / 512, c = (n - 1024) % 512, head = c / 64, dim = c % 64;
    const int pn = 4 + 2 * s + head / 4, wc = head % 4, bj = dim / 32, w = dim % 32;
    return 256 * pn + 128 * bj + 32 * wc + w;
}
__host__ __device__ __forceinline__ void win_row_inv(int row, int& s, int& head, int& dim) {
    const int pn = row / 256, tl = row % 256, bj = tl / 128, wc = (tl % 128) / 32, w = tl % 32;
    s = (pn - 4) / 2; head = ((pn - 4) & 1) * 4 + wc; dim = 32 * bj + w;
}
__host__ __device__ __forceinline__ int gu_row(int j, int up) { return (j / 128) * 256 + up * 128 + (j % 128); }

template <class RowMap>
__device__ __forceinline__ void transpose_item(const float* W, int N, int k0, int n0, const float* gain, bf16* WT, int Kdst, RowMap rm, LAS float* scr, int lane) {
#pragma unroll 8
    for (int i = 0; i < 32; ++i) { const int kk = 2 * i + (lane >> 5); float v = W[(size_t)(k0 + kk) * N + n0 + (lane & 31)]; if (gain) v *= gain[k0 + kk]; scr[kk * 33 + (lane & 31)] = v; }
    asm volatile("s_waitcnt lgkmcnt(0)" ::: "memory");
    const int c = lane & 7;
#pragma unroll
    for (int j = 0; j < 4; ++j) { const int n = (lane >> 3) + 8 * j; const LAS float* s = scr + (8 * c) * 33 + n;
        u32x4 o; o.x = pk2(s[0 * 33], s[1 * 33]); o.y = pk2(s[2 * 33], s[3 * 33]); o.z = pk2(s[4 * 33], s[5 * 33]); o.w = pk2(s[6 * 33], s[7 * 33]);
        *(u32x4*)(WT + (size_t)rm(n0 + n) * Kdst + k0 + 8 * c) = o; }
    asm volatile("s_waitcnt lgkmcnt(0)" ::: "memory");
}
struct RmId { __device__ int operator()(int n) const { return n; } };
struct RmWin { __device__ int operator()(int n) const { return win_row(n); } };
struct RmGu { int up; __device__ int operator()(int n) const { return gu_row(n, up); } };

__device__ __forceinline__ void p0_prologue(const Params& p, LAS unsigned char* lds, int gw, int NGW, int lane, int wave) {
    LAS float* scr = (LAS float*)(lds + wave * 16384);
    unsigned char* ws = p.ws;
    constexpr int I_WIN = 16 * 80, I_WOUT = 16 * 32, I_G = 16 * 16, I_D = 8 * 32;
    constexpr int I_LAYER = I_WIN + I_WOUT + NE * (2 * I_G + I_D);
    for (int it = gw; it < DEPTH * I_LAYER; it += NGW) {
        const int l = it / I_LAYER; int r = it % I_LAYER;
        if (r < I_WIN) { const int kb = r / 80, nb = r % 80;
            transpose_item(p.in[2] + (size_t)l * D * DIN, DIN, 64 * kb, 32 * nb, p.in[1] + l * D, (bf16*)(ws + WS_WIN) + (size_t)l * DIN * D, D, RmWin{}, scr, lane); continue; }
        r -= I_WIN;
        if (r < I_WOUT) { const int kb = r / 32, nb = r % 32;
            transpose_item(p.in[14] + (size_t)l * D * D, D, 64 * kb, 32 * nb, nullptr, (bf16*)(ws + WS_WOUT) + (size_t)l * D * D, D, RmId{}, scr, lane); continue; }
        r -= I_WOUT;
        const int e = r / (2 * I_G + I_D); r %= (2 * I_G + I_D);
        bf16* gu = (bf16*)(ws + WS_WGU) + ((size_t)l * NE + e) * 1024 * 1024;
        if (r < I_G) { const int kb = r / 16, nb = r % 16;
            transpose_item(p.in[20] + ((size_t)l * NE + e) * D * DE, DE, 64 * kb, 32 * nb, p.in[15] + l * D, gu, D, RmGu{0}, scr, lane); continue; }
        r -= I_G;
        if (r < I_G) { const int kb = r / 16, nb = r % 16;
            transpose_item(p.in[21] + ((size_t)l * NE + e) * D * DE, DE, 64 * kb, 32 * nb, p.in[15] + l * D, gu, D, RmGu{1}, scr, lane); continue; }
        r -= I_G;
        { const int kb = r / 32, nb = r % 32;
            transpose_item(p.in[22] + ((size_t)l * NE + e) * DE * D, D, 64 * kb, 32 * nb, nullptr, (bf16*)(ws + WS_WD) + ((size_t)l * NE + e) * D * DE, DE, RmId{}, scr, lane); }
    }
    const int gt = gw * 64 + lane, NGT = NGW * 64;
    for (int i = gt; i < DEPTH * 48 * 1024; i += NGT) {
        const int l = i / (48 * 1024), col = (i / 1024) % 48, k = i % 1024;
        float w = 0.f;
        if (col < 32) w = p.in[18][((size_t)l * D + k) * 32 + col]; else if (col < 36) w = p.in[16][((size_t)l * D + k) * 4 + (col - 32)];
        w *= p.in[15][l * D + k];
        const unsigned hi = f2bf(w); const float res = w - bf2f(hi);
        bf16* wr = (bf16*)(ws + WS_WR) + (size_t)l * 2 * 48 * 1024;
        wr[col * 1024 + k] = (bf16)hi; wr[48 * 1024 + col * 1024 + k] = (bf16)f2bf(res);
    }
    for (int i = gt; i < DEPTH * 2 * 8 * 64 * 64; i += NGT) {
        const int l = i / (2 * 8 * 4096), which = (i / (8 * 4096)) % 2, h = (i / 4096) % 8, n = (i / 64) % 64, k = i % 64;
        const float* src = p.in[which ? 7 : 5] + ((size_t)l * 8 + h) * 4096;
        ((bf16*)(ws + WS_LRUW))[i] = (bf16)f2bf(src[k * 64 + n]);
    }
    for (int i = gt; i < DEPTH * 512; i += NGT) { const float lam = p.in[9][i]; ((float*)(ws + WS_SP))[i] = log1pf(__expf(-lam)); }
    for (int m = gw; m < T; m += NGW) {
        const f32x4* xr = (const f32x4*)(p.in[0] + (size_t)m * D) + lane; f32x4* orow = (f32x4*)(p.out + (size_t)m * D) + lane;
        u32x2* xb = (u32x2*)((bf16*)(ws + WS_XB) + (size_t)m * D) + lane;
        float s = 0.f;
#pragma unroll
        for (int j = 0; j < 4; ++j) { const f32x4 v = xr[64 * j]; s += (v.x * v.x + v.y * v.y) + (v.z * v.z + v.w * v.w); orow[64 * j] = v; u32x2 w; w.x = pk2(v.x, v.y); w.y = pk2(v.z, v.w); xb[64 * j] = w; }
        s = wave_sum(s);
        if (lane == 0) ((float*)(ws + WS_RSTD1))[m] = 1.f / sqrtf(s * (1.f / D) + EPS);
    }
}
__global__ void __launch_bounds__(512) k_prologue(Params p) {
    extern __shared__ __attribute__((aligned(16))) unsigned char lds[];
    const int lane = threadIdx.x & 63, wave = threadIdx.x >> 6;
    p0_prologue(p, (LAS unsigned char*)lds, blockIdx.x * 8 + wave, gridDim.x * 8, lane, wave);
}

template <class Epi>
__global__ void __launch_bounds__(256) ngemm(const bf16* A, const bf16* Bt, int M, int N, int K, Epi epi) {
    const int lane = threadIdx.x & 63, wv = blockIdx.x * 4 + (threadIdx.x >> 6);
    const int tn_n = N / 64, tm = wv / tn_n, tn = wv % tn_n;
    if (tm >= M / 64) return;
    const int r16 = lane & 15, q4 = lane >> 4;
    f32x4 acc[4][4];
#pragma unroll
    for (int i = 0; i < 4; ++i)
#pragma unroll
        for (int j = 0; j < 4; ++j) acc[i][j] = (f32x4){0.f, 0.f, 0.f, 0.f};
    for (int k0 = 0; k0 < K; k0 += 32) {
        bf16x8 a[4], b[4];
#pragma unroll
        for (int i = 0; i < 4; ++i) { a[i] = *(const bf16x8*)(A + (size_t)(tm * 64 + i * 16 + r16) * K + k0 + 8 * q4); b[i] = *(const bf16x8*)(Bt + (size_t)(tn * 64 + i * 16 + r16) * K + k0 + 8 * q4); }
#pragma unroll
        for (int i = 0; i < 4; ++i)
#pragma unroll
            for (int j = 0; j < 4; ++j) acc[i][j] = __builtin_amdgcn_mfma_f32_16x16x32_bf16(a[i], b[j], acc[i][j], 0, 0, 0);
    }
#pragma unroll
    for (int i = 0; i < 4; ++i)
#pragma unroll
        for (int j = 0; j < 4; ++j)
#pragma unroll
            for (int r = 0; r < 4; ++r) epi(tm * 64 + i * 16 + 4 * q4 + r, tn * 64 + j * 16 + r16, acc[i][j][r]);
}
struct EpiProjN {
    const float* rstd; bf16 *xl, *gg, *v; float* qk;
    __device__ void operator()(int row, int n, float a) const {
        const float val = a * rstd[row];
        if (n < 512) xl[(size_t)row * 512 + n] = (bf16)f2bf(val);
        else if (n < 1024) gg[(size_t)row * 512 + n - 512] = (bf16)f2bf(gelu_tanh(val));
        else if (n < 2048) { int s, head, dim; win_row_inv(n, s, head, dim); qk[(size_t)row * 1024 + s * 512 + head * 64 + dim] = val; }
        else v[(size_t)row * 512 + n - 2048] = (bf16)f2bf(val);
    }
};
__global__ void n_qknorm(const float* qk, const float* qg, const float* kg, bf16* q, bf16* k) {
    const int i = blockIdx.x * blockDim.x + threadIdx.x; if (i >= T * 16) return;
    const int row = i / 16, s = (i / 8) % 2, head = i % 8;
    const float* src = qk + (size_t)row * 1024 + s * 512 + head * 64;
    float ss = 0.f; for (int d = 0; d < 64; ++d) ss += src[d] * src[d];
    const float r = 1.f / sqrtf(ss * (1.f / 64.f) + EPS);
    bf16* dst = (s ? k : q) + (size_t)row * 512 + head * 64;
    for (int d = 0; d < 64; ++d) dst[d] = (bf16)f2bf(src[d] * r * (s ? kg[d] : qg[d] * QSCALE));
}
__global__ void __launch_bounds__(256) n_attn(const bf16* q, const bf16* k, const bf16* v, bf16* obr, float* lbr) {
    const int i = blockIdx.x * blockDim.x + threadIdx.x; if (i >= T * 8) return;
    const int t = i / 8, h = i % 8, b = t / SEQ, pos = t % SEQ;
    float qf[64];
    { const bf16* qp = q + (size_t)t * 512 + h * 64;
#pragma unroll
      for (int d = 0; d < 64; ++d) qf[d] = bf2f(qp[d]); }
    for (int br = 0; br < 3; ++br) {
        const int dil = br == 0 ? 1 : (br == 1 ? 4 : 16);
        float o[64];
#pragma unroll
        for (int d = 0; d < 64; ++d) o[d] = 0.f;
        float l = 0.f;
        for (int m = 0; m <= 128; ++m) {
            const int kp = pos - m * dil; if (kp < 0) break;
            const size_t off = ((size_t)b * SEQ + kp) * 512 + h * 64;
            float s = 0.f;
#pragma unroll
            for (int d8 = 0; d8 < 8; ++d8) { const bf16x8 kv = *(const bf16x8*)(k + off + d8 * 8);
#pragma unroll
                for (int j = 0; j < 8; ++j) s += qf[d8 * 8 + j] * bf2f((unsigned short)kv[j]); }
            const float pw = exp2f(s); l += pw;
#pragma unroll
            for (int d8 = 0; d8 < 8; ++d8) { const bf16x8 vv = *(const bf16x8*)(v + off + d8 * 8);
#pragma unroll
                for (int j = 0; j < 8; ++j) o[d8 * 8 + j] += pw * bf2f((unsigned short)vv[j]); }
        }
        const float rl = 1.f / l;
        bf16* op = obr + (size_t)br * T * 512 + (size_t)t * 512 + h * 64;
#pragma unroll
        for (int d = 0; d < 64; ++d) op[d] = (bf16)f2bf(o[d] * rl);
        lbr[(size_t)br * T * 8 + (size_t)t * 8 + h] = l;
    }
}
__global__ void __launch_bounds__(256) n_lru_au(const bf16* xl, const float* cw, const float* cb, const bf16* wat, const bf16* wxt, const float* ba, const float* bx, const float* sp, float* a_out, float* u_out) {
    const int i = blockIdx.x * blockDim.x + threadIdx.x; if (i >= T * 512) return;
    const int t = i / 512, c = i % 512, pos = t % SEQ, h = c / 64, n = c % 64;
    float ra = 0.f, rx = 0.f, xc_own = 0.f;
    for (int kk = 0; kk < 64; ++kk) {
        const int ch = h * 64 + kk; float xc = cb[ch];
        for (int j = 0; j < 4; ++j) { const int pp = pos - 3 + j; if (pp >= 0) xc += cw[j * 512 + ch] * bf2f(xl[(size_t)(t - 3 + j) * 512 + ch]); }
        if (kk == n) xc_own = xc;
        const float xcb = bf2f(f2bf(xc));
        ra += xcb * bf2f(wat[(h * 64 + n) * 64 + kk]); rx += xcb * bf2f(wxt[(h * 64 + n) * 64 + kk]);
    }
    const float r = sigmoidf_(ra + ba[c]), ig = sigmoidf_(rx + bx[c]);
    const float log_a = -8.f * r * sp[c];
    const float a = __expf(log_a);
    a_out[i] = a; u_out[i] = sqrtf(fmaxf(1.f - a * a, 0.f)) * (ig * xc_own);
}
__global__ void n_lru_scan(const float* a_in, const float* u_in, bf16* hl, bf16* pc, float* aggA, float* aggH) {
    const int i = blockIdx.x * blockDim.x + threadIdx.x; if (i >= NB * NCHUNK * 512) return;
    const int c = i % 512, bc = i / 512;
    float h = 0.f, P = 1.f;
    for (int j = 0; j < 32; ++j) { const size_t idx = ((size_t)bc * 32 + j) * 512 + c; const float a = a_in[idx]; h = a * h + u_in[idx]; P *= a; hl[idx] = (bf16)f2bf(h); pc[idx] = (bf16)f2bf(P); }
    aggA[i] = P; aggH[i] = h;
}
__global__ void n_lru_carry(const float* aggA, const float* aggH, float* carry) {
    const int i = blockIdx.x * blockDim.x + threadIdx.x; if (i >= NB * 512) return;
    const int b = i / 512, c = i % 512; float h = 0.f;
    for (int ch = 0; ch < NCHUNK; ++ch) { const size_t idx = ((size_t)b * NCHUNK + ch) * 512 + c; carry[idx] = h; h = aggA[idx] * h + aggH[idx]; }
}
__global__ void __launch_bounds__(256) n_merge(const bf16* hl, const bf16* pc, const bf16* gg, const float* carry, const bf16* obr, const float* lbr, const float* gl, const float* ga, bf16* merged) {
    __shared__ float red[8];
    const int t = blockIdx.x, tid = threadIdx.x;
    float yl[2], ya[2]; float s1 = 0.f, s2 = 0.f;
    for (int j = 0; j < 2; ++j) { const int c = tid + 256 * j; const size_t idx = (size_t)t * 512 + c;
        const float h = bf2f(hl[idx]) + bf2f(pc[idx]) * carry[(size_t)(t / 32) * 512 + c];
        yl[j] = h * bf2f(gg[idx]); s1 += yl[j] * yl[j];
        const int hd = c / 64; float num = 0.f, den = 0.f;
        for (int br = 0; br < 3; ++br) { const float l = lbr[(size_t)br * T * 8 + (size_t)t * 8 + hd]; num += l * bf2f(obr[(size_t)br * T * 512 + idx]); den += l; }
        ya[j] = num / den; s2 += ya[j] * ya[j]; }
    s1 = wave_sum(s1); s2 = wave_sum(s2);
    if ((tid & 63) == 0) { red[tid >> 6] = s1; red[4 + (tid >> 6)] = s2; }
    __syncthreads();
    const float r1 = 1.f / sqrtf((red[0] + red[1] + red[2] + red[3]) * (1.f / 512.f) + EPS), r2 = 1.f / sqrtf((red[4] + red[5] + red[6] + red[7]) * (1.f / 512.f) + EPS);
    for (int j = 0; j < 2; ++j) { const int c = tid + 256 * j;
        merged[(size_t)t * 1024 + c] = (bf16)f2bf(yl[j] * r1 * gl[c]); merged[(size_t)t * 1024 + 512 + c] = (bf16)f2bf(ya[j] * r2 * ga[c]); }
}
struct EpiOutN { float* x; bf16* xb; __device__ void operator()(int row, int n, float a) const { const size_t i = (size_t)row * 1024 + n; const float v = x[i] + a; x[i] = v; xb[i] = (bf16)f2bf(v); } };
__global__ void __launch_bounds__(256) n_router(const float* x, const bf16* wr, const float* bg, const float* be, float* rstd2, unsigned* counts, int* asg_e, int* asg_pos, float* asg_w, int* list) {
    const int lane = threadIdx.x & 63, t = blockIdx.x * 4 + (threadIdx.x >> 6);
    const float* xr = x + (size_t)t * 1024;
    float xv[16]; float ss = 0.f;
#pragma unroll
    for (int j = 0; j < 16; ++j) { xv[j] = xr[lane + 64 * j]; ss += xv[j] * xv[j]; }
    ss = wave_sum(ss); const float rs = 1.f / sqrtf(ss * (1.f / 1024.f) + EPS);
    __shared__ float slg[4][36];
    float* lg = slg[threadIdx.x >> 6];
    for (int c = 0; c < 36; ++c) { float s = 0.f;
#pragma unroll
        for (int j = 0; j < 16; ++j) { const int k = lane + 64 * j; s += xv[j] * (bf2f(wr[c * 1024 + k]) + bf2f(wr[48 * 1024 + c * 1024 + k])); }
        s = wave_sum(s) * rs + (c < 32 ? be[c] : bg[c - 32]); if (lane == 0) lg[c] = s; }
    if (lane == 0) {
        rstd2[t] = rs;
        int g = 0; float gm = lg[32]; for (int j = 1; j < 4; ++j) if (lg[32 + j] > gm) { gm = lg[32 + j]; g = j; }
        float den = 0.f; for (int j = 0; j < 4; ++j) den += __expf(lg[32 + j] - gm);
        const float ptop = 1.f / den;
        int i1 = 0; float v1 = lg[g * 8]; for (int j = 1; j < 8; ++j) if (lg[g * 8 + j] > v1) { v1 = lg[g * 8 + j]; i1 = j; }
        int i2 = -1; float v2 = -INFINITY; for (int j = 0; j < 8; ++j) if (j != i1 && lg[g * 8 + j] > v2) { v2 = lg[g * 8 + j]; i2 = j; }
        const float e2 = __expf(v2 - v1), w1 = ptop / (1.f + e2), w2 = ptop * e2 / (1.f + e2);
        const int ea = g * 8 + i1, eb = g * 8 + i2;
        const int pa = (int)atomicAdd(&counts[ea], 1u), pb = (int)atomicAdd(&counts[eb], 1u);
        asg_e[2 * t] = ea; asg_pos[2 * t] = pa; asg_w[2 * t] = w1; list[(size_t)ea * T + pa] = 2 * t;
        asg_e[2 * t + 1] = eb; asg_pos[2 * t + 1] = pb; asg_w[2 * t + 1] = w2; list[(size_t)eb * T + pb] = 2 * t + 1;
    }
}
__device__ __forceinline__ void moe_plan(const unsigned* counts, int* tstart  ) {
    if (threadIdx.x == 0) { int acc = 0; for (int e = 0; e < NE; ++e) { tstart[e] = acc; acc += ((int)counts[e] + 255) / 256; } tstart[NE] = acc; }
    __syncthreads();
}
__global__ void __launch_bounds__(256) n_moe_up(const bf16* xb, const bf16* wgu, const float* rstd2, const unsigned* counts, const int* list, bf16* hid) {
    __shared__ int tstart[33];
    moe_plan(counts, tstart);
    const int lane = threadIdx.x & 63, wv = blockIdx.x * 4 + (threadIdx.x >> 6);
    const int rt64 = wv / 16, jb = wv % 16, rt = rt64 / 4;
    if (rt >= tstart[NE]) return;
    int e = 0; while (tstart[e + 1] <= rt) ++e;
    const int cnt = (int)counts[e], pos0 = (rt - tstart[e]) * 256 + (rt64 % 4) * 64;
    if (pos0 >= cnt) return;
    const int r16 = lane & 15, q4 = lane >> 4;
    const bf16* W = wgu + (size_t)e * 1024 * 1024;
    int tok[4];
#pragma unroll
    for (int i = 0; i < 4; ++i) { int pos = pos0 + i * 16 + r16; if (pos >= cnt) pos = pos0; tok[i] = list[(size_t)e * T + pos] >> 1; }
    f32x4 ag[4][2], au[4][2];
#pragma unroll
    for (int i = 0; i < 4; ++i)
#pragma unroll
        for (int j = 0; j < 2; ++j) { ag[i][j] = (f32x4){0.f, 0.f, 0.f, 0.f}; au[i][j] = (f32x4){0.f, 0.f, 0.f, 0.f}; }
    for (int k0 = 0; k0 < 1024; k0 += 32) {
        bf16x8 a[4], bg_[2], bu_[2];
#pragma unroll
        for (int i = 0; i < 4; ++i) a[i] = *(const bf16x8*)(xb + (size_t)tok[i] * 1024 + k0 + 8 * q4);
#pragma unroll
        for (int j = 0; j < 2; ++j) { const int col = jb * 32 + j * 16 + r16; bg_[j] = *(const bf16x8*)(W + (size_t)gu_row(col, 0) * 1024 + k0 + 8 * q4); bu_[j] = *(const bf16x8*)(W + (size_t)gu_row(col, 1) * 1024 + k0 + 8 * q4); }
#pragma unroll
        for (int i = 0; i < 4; ++i)
#pragma unroll
            for (int j = 0; j < 2; ++j) { ag[i][j] = __builtin_amdgcn_mfma_f32_16x16x32_bf16(a[i], bg_[j], ag[i][j], 0, 0, 0); au[i][j] = __builtin_amdgcn_mfma_f32_16x16x32_bf16(a[i], bu_[j], au[i][j], 0, 0, 0); }
    }
#pragma unroll
    for (int i = 0; i < 4; ++i)
#pragma unroll
        for (int r = 0; r < 4; ++r) { const int pos = pos0 + i * 16 + 4 * q4 + r; if (pos >= cnt) continue;
            const int tk = list[(size_t)e * T + pos] >> 1; const float rs = rstd2[tk];
#pragma unroll
            for (int j = 0; j < 2; ++j) { const float g = ag[i][j][r] * rs, u = au[i][j][r] * rs; const float hv = g * sigmoidf_(g) * u;
                hid[(size_t)(tstart[e] * 256 + pos) * 512 + jb * 32 + j * 16 + r16] = (bf16)f2bf(hv); } }
}
__global__ void __launch_bounds__(256) n_moe_down(const bf16* hid, const bf16* wd, const unsigned* counts, const int* list, const float* asg_w, bf16* ys) {
    __shared__ int tstart[33];
    moe_plan(counts, tstart);
    const int lane = threadIdx.x & 63, wv = blockIdx.x * 4 + (threadIdx.x >> 6);
    const int rt64 = wv / 16, nb = wv % 16, rt = rt64 / 4;
    if (rt >= tstart[NE]) return;
    int e = 0; while (tstart[e + 1] <= rt) ++e;
    const int cnt = (int)counts[e], pos0 = (rt - tstart[e]) * 256 + (rt64 % 4) * 64;
    if (pos0 >= cnt) return;
    const int r16 = lane & 15, q4 = lane >> 4;
    const bf16* W = wd + (size_t)e * 1024 * 512;
    const size_t rowbase = (size_t)tstart[e] * 256;
    f32x4 acc[4][4];
#pragma unroll
    for (int i = 0; i < 4; ++i)
#pragma unroll
        for (int j = 0; j < 4; ++j) acc[i][j] = (f32x4){0.f, 0.f, 0.f, 0.f};
    for (int k0 = 0; k0 < 512; k0 += 32) {
        bf16x8 a[4], b[4];
#pragma unroll
        for (int i = 0; i < 4; ++i) { int pos = pos0 + i * 16 + r16; if (pos >= cnt) pos = pos0; a[i] = *(const bf16x8*)(hid + (rowbase + pos) * 512 + k0 + 8 * q4); b[i] = *(const bf16x8*)(W + (size_t)(nb * 64 + i * 16 + r16) * 512 + k0 + 8 * q4); }
#pragma unroll
        for (int i = 0; i < 4; ++i)
#pragma unroll
            for (int j = 0; j < 4; ++j) acc[i][j] = __builtin_amdgcn_mfma_f32_16x16x32_bf16(a[i], b[j], acc[i][j], 0, 0, 0);
    }
#pragma unroll
    for (int i = 0; i < 4; ++i)
#pragma unroll
        for (int r = 0; r < 4; ++r) { const int pos = pos0 + i * 16 + 4 * q4 + r; if (pos >= cnt) continue;
            const float gw = asg_w[list[(size_t)e * T + pos]];
#pragma unroll
            for (int j = 0; j < 4; ++j) ys[(rowbase + pos) * 1024 + nb * 64 + j * 16 + r16] = (bf16)f2bf(acc[i][j][r] * gw); }
}
__global__ void __launch_bounds__(256) n_combine(float* x, bf16* xb, float* rstd1, const bf16* ys, const unsigned* counts, const int* asg_e, const int* asg_pos) {
    __shared__ int tstart[33]; __shared__ float red[4];
    moe_plan(counts, tstart);
    const int t = blockIdx.x, tid = threadIdx.x;
    const size_t r0 = (size_t)tstart[asg_e[2 * t]] * 256 + asg_pos[2 * t], r1 = (size_t)tstart[asg_e[2 * t + 1]] * 256 + asg_pos[2 * t + 1];
    float s = 0.f;
    for (int j = 0; j < 4; ++j) { const int c = tid + 256 * j; const size_t i = (size_t)t * 1024 + c;
        const float v = x[i] + bf2f(ys[r0 * 1024 + c]) + bf2f(ys[r1 * 1024 + c]); x[i] = v; xb[i] = (bf16)f2bf(v); s += v * v; }
    s = wave_sum(s); if ((tid & 63) == 0) red[tid >> 6] = s; __syncthreads();
    if (tid == 0) rstd1[t] = 1.f / sqrtf((red[0] + red[1] + red[2] + red[3]) * (1.f / 1024.f) + EPS);
}

extern "C" void kernel_launch(void* const* d_in, const int* in_sizes, int n_in, void* d_out, int out_size, void* d_ws, size_t ws_size, hipStream_t stream) {
    if (n_in != 23 || ws_size < WS_END) { fprintf(stderr, "kernel_launch: unexpected n_in %d or ws_size %zu (< %zu)\n", n_in, ws_size, (size_t)WS_END); return; }
    Params p{};
    for (int i = 0; i < 23; ++i) p.in[i] = (const float*)d_in[i];
    p.out = (float*)d_out; p.ws = (unsigned char*)d_ws;
    unsigned char* ws = (unsigned char*)d_ws;
    hipMemsetAsync(ws + WS_CTL, 0, CTL_BYTES, stream);
    static bool attr = false;
    if (!attr) { hipFuncSetAttribute((const void*)k_prologue, hipFuncAttributeMaxDynamicSharedMemorySize, 131072); attr = true; }
    hipLaunchKernelGGL(k_prologue, dim3(256), dim3(512), 131072, stream, p);
    unsigned char* act = ws + WS_ACT;
    bf16 *xb = (bf16*)(ws + WS_XB), *xl = (bf16*)(act + A_XL), *gg = (bf16*)(act + A_GG), *q = (bf16*)(act + A_Q), *k = (bf16*)(act + A_K), *v = (bf16*)(act + A_V);
    bf16 *obr = (bf16*)(act + A_OBR), *hl = (bf16*)(act + A_HL), *pc = (bf16*)(act + A_PC), *merged = (bf16*)(act + A_MERGED), *hid = (bf16*)(act + A_HID), *ys = (bf16*)(act + A_YS);
    float *lbr = (float*)(act + A_LBR), *aggA = (float*)(act + A_AGG), *aggH = aggA + NB * NCHUNK * 512, *carry = aggH + NB * NCHUNK * 512;
    float *rstd1 = (float*)(ws + WS_RSTD1), *rstd2 = (float*)(ws + WS_RSTD2), *tmp = (float*)(ws + WS_TMP);
    int *asg_e = (int*)(ws + WS_ASG), *asg_pos = asg_e + 2 * T; float* asg_w = (float*)(asg_pos + 2 * T); int* list = (int*)(ws + WS_LIST);
    float* x = (float*)d_out;
    for (int l = 0; l < DEPTH; ++l) {
        const bf16* win = (const bf16*)(ws + WS_WIN) + (size_t)l * DIN * D; const bf16* wout = (const bf16*)(ws + WS_WOUT) + (size_t)l * D * D;
        const bf16* wgu = (const bf16*)(ws + WS_WGU) + (size_t)l * NE * 1024 * 1024; const bf16* wd = (const bf16*)(ws + WS_WD) + (size_t)l * NE * 1024 * 512;
        const bf16* wr = (const bf16*)(ws + WS_WR) + (size_t)l * 2 * 48 * 1024; const bf16* wat = (const bf16*)(ws + WS_LRUW) + (size_t)l * 2 * 8 * 4096; const bf16* wxt = wat + 8 * 4096;
        const float* sp = (const float*)(ws + WS_SP) + l * 512; unsigned* counts = (unsigned*)(ws + WS_CTL) + CW_CNT + 64 * l;
        hipLaunchKernelGGL(ngemm<EpiProjN>, dim3((T / 64) * (DIN / 64) / 4), dim3(256), 0, stream, xb, win, T, DIN, D, EpiProjN{rstd1, xl, gg, v, tmp});
        hipLaunchKernelGGL(n_qknorm, dim3(T * 16 / 256), dim3(256), 0, stream, tmp, p.in[10] + l * 64, p.in[11] + l * 64, q, k);
        hipLaunchKernelGGL(n_attn, dim3(T * 8 / 256), dim3(256), 0, stream, q, k, v, obr, lbr);
        float* a_tmp = tmp; float* u_tmp = tmp + (size_t)T * 512;
        hipLaunchKernelGGL(n_lru_au, dim3(T * 512 / 256), dim3(256), 0, stream, xl, p.in[3] + l * 4 * 512, p.in[4] + l * 512, wat, wxt, p.in[6] + l * 512, p.in[8] + l * 512, sp, a_tmp, u_tmp);
        hipLaunchKernelGGL(n_lru_scan, dim3(NB * NCHUNK * 512 / 256), dim3(256), 0, stream, a_tmp, u_tmp, hl, pc, aggA, aggH);
        hipLaunchKernelGGL(n_lru_carry, dim3(NB * 512 / 256), dim3(256), 0, stream, aggA, aggH, carry);
        hipLaunchKernelGGL(n_merge, dim3(T), dim3(256), 0, stream, hl, pc, gg, carry, obr, lbr, p.in[12] + l * 512, p.in[13] + l * 512, merged);
        hipLaunchKernelGGL(ngemm<EpiOutN>, dim3((T / 64) * (D / 64) / 4), dim3(256), 0, stream, merged, wout, T, D, D, EpiOutN{x, xb});
        hipLaunchKernelGGL(n_router, dim3(T / 4), dim3(256), 0, stream, x, wr, p.in[17] + l * 4, p.in[19] + l * 32, rstd2, counts, asg_e, asg_pos, asg_w, list);
        hipLaunchKernelGGL(n_moe_up, dim3((SLAB_ROWS / 64) * 16 / 4), dim3(256), 0, stream, xb, wgu, rstd2, counts, list, hid);
        hipLaunchKernelGGL(n_moe_down, dim3((SLAB_ROWS / 64) * 16 / 4), dim3(256), 0, stream, hid, wd, counts, list, asg_w, ys);
        hipLaunchKernelGGL(n_combine, dim3(T), dim3(256), 0, stream, x, xb, rstd1, ys, counts, asg_e, asg_pos);
    }
}
```

```cpp
#include <hip/hip_runtime.h>
#include <hip/hip_cooperative_groups.h>
#include <cstdio>
#include <cstdint>
#include <cmath>

constexpr int NB = 8, SEQ = 4096, T = NB * SEQ, D = 1024, DEPTH = 4;
constexpr int DL = 512, DA = 512, NHEAD = 8, HD = 64, DIN = 2560;
constexpr int NE = 32, DE = 512, NGRP = 4, EPG = 8;
constexpr int NCHUNK = SEQ / 32;
constexpr int SLAB_ROWS = 2 * T + NE * 256;
constexpr float EPS = 1e-6f;
constexpr float QSCALE = 0.125f * 1.4426950408889634f;

typedef unsigned short bf16;
typedef short bf16x8 __attribute__((ext_vector_type(8)));
typedef float f32x4 __attribute__((ext_vector_type(4)));
typedef unsigned u32x4 __attribute__((ext_vector_type(4)));
typedef unsigned u32x2 __attribute__((ext_vector_type(2)));
#define LAS __attribute__((address_space(3)))

constexpr size_t MiB = 1u << 20;
constexpr size_t WS_CTL = 0, CTL_BYTES = 1 * MiB;
constexpr size_t WS_WIN = 1 * MiB;
constexpr size_t WS_WOUT = WS_WIN + 20 * MiB;
constexpr size_t WS_WGU = WS_WOUT + 8 * MiB;
constexpr size_t WS_WD = WS_WGU + 256 * MiB;
constexpr size_t WS_WR = WS_WD + 128 * MiB;
constexpr size_t WS_LRUW = WS_WR + 1 * MiB;
constexpr size_t WS_SP = WS_LRUW + 1 * MiB;
constexpr size_t WS_XB = WS_SP + 1 * MiB;
constexpr size_t WS_RSTD1 = WS_XB + 64 * MiB;
constexpr size_t WS_RSTD2 = WS_RSTD1 + 128 * 1024;
constexpr size_t WS_ASG = WS_RSTD2 + 128 * 1024;
constexpr size_t WS_LIST = WS_ASG + 1 * MiB;
constexpr size_t WS_ACT = WS_LIST + 4 * MiB;
constexpr size_t A_XL = 0, A_GG = 32 * MiB, A_Q = 64 * MiB, A_K = 96 * MiB, A_V = 128 * MiB;
constexpr size_t A_OBR = 160 * MiB;
constexpr size_t A_LBR = 256 * MiB;
constexpr size_t A_HL = 260 * MiB, A_PC = 292 * MiB;
constexpr size_t A_AGG = 324 * MiB;
static_assert(A_GG - A_XL == (size_t)T * 512 * 2 && A_Q - A_GG == A_GG - A_XL && A_K - A_Q == A_GG - A_XL && A_V - A_K == A_GG - A_XL, "EpiProj section stride");
constexpr size_t A_MERGED = A_Q;
constexpr size_t A_HID = 0;
constexpr size_t A_YS = 72 * MiB;
constexpr size_t ACT_BYTES = 332 * MiB;
constexpr size_t WS_TMP = WS_ACT + ACT_BYTES;
constexpr size_t WS_END = WS_TMP + 128 * MiB;
static_assert(WS_END <= 1024 * MiB, "workspace map must fit 1 GiB");
constexpr int CW_CNT = 64;

struct Params {
    const float* in[23];
    float* out;
    unsigned char* ws;
};
constexpr int NWAVES = 8, NTHREADS = 512;
constexpr int LDS_BYTES = 147456;
constexpr int LDS_MISC = 143360;
constexpr int LDS_TAB = LDS_MISC + 3072;
constexpr int CW_BAR = 4096;
struct Ctx { unsigned char* ws; float* out; LAS unsigned char* lds; int tid, lane, wave, G, bid, gw, NGW, gt, NGT, l; };
#define GAS __attribute__((address_space(1)))
__device__ __forceinline__ unsigned char* as_global(unsigned long long a) { return (unsigned char*)(GAS unsigned char*)a; }
__device__ __forceinline__ const float* inp(const Ctx& c, int i) {
    const LAS unsigned* tab = (const LAS unsigned*)(c.lds + LDS_TAB) + 2 * i;
    const unsigned lo = __builtin_amdgcn_readfirstlane(tab[0]), hi = __builtin_amdgcn_readfirstlane(tab[1]);
    return (const float*)as_global(((unsigned long long)hi << 32) | lo);
}
__device__ __forceinline__ Ctx fresh(const Ctx& c0) {
    Ctx c; unsigned long long w = (unsigned long long)c0.ws, o = (unsigned long long)c0.out; unsigned l3 = (unsigned)(uintptr_t)c0.lds; int t = c0.tid, G = c0.G, b = c0.bid, l = c0.l;
    asm volatile("" : "+s"(w), "+s"(o), "+s"(l3), "+v"(t), "+s"(G), "+s"(b), "+s"(l));
    c.ws = as_global(w); c.out = (float*)as_global(o); c.lds = (LAS unsigned char*)(uintptr_t)l3; c.tid = t; c.lane = t & 63; c.wave = __builtin_amdgcn_readfirstlane(t >> 6); c.G = G; c.bid = b; c.l = l;
    c.gw = b * NWAVES + c.wave; c.NGW = G * NWAVES; c.gt = b * NTHREADS + t; c.NGT = G * NTHREADS; return c;
}
__device__ __forceinline__ unsigned char* wsl(const Ctx& c) { unsigned long long w = (unsigned long long)c.ws; asm volatile("" : "+s"(w)); return as_global(w); }

__device__ __forceinline__ unsigned pk2(float lo, float hi) { unsigned r; asm("v_cvt_pk_bf16_f32 %0, %1, %2" : "=v"(r) : "v"(lo), "v"(hi)); return r; }
__device__ __forceinline__ unsigned f2bf(float f) { return pk2(f, 0.f) & 0xffffu; }
__device__ __forceinline__ float bf2f(unsigned h) { return __builtin_bit_cast(float, h << 16); }
__device__ __forceinline__ float shx(float v, int lane, int o) { return __builtin_bit_cast(float, __builtin_amdgcn_ds_bpermute((lane ^ o) << 2, __builtin_bit_cast(int, v))); }
__device__ __forceinline__ float wave_sum(float v, int lane) {
#pragma unroll
    for (int o = 1; o < 64; o <<= 1) v += shx(v, lane, o);
    return v;
}
__device__ __forceinline__ float frcp(float x) { return __builtin_amdgcn_rcpf(x); }
__device__ __forceinline__ float fsqrt(float x) { return __builtin_amdgcn_sqrtf(x); }
__device__ __forceinline__ float frsq(float x) { return __builtin_amdgcn_rsqf(x); }
__device__ __forceinline__ float fexp(float x) { return __builtin_amdgcn_exp2f(x * 1.4426950408889634f); }
__device__ __forceinline__ float gelu_tanh(float x) {
    const float z = 0.7978845608028654f * (x + 0.044715f * x * x * x);
    const float e = fexp(2.f * z);
    return (e > 3.0e38f) ? x : x * e * frcp(1.f + e);
}
__device__ __forceinline__ float sigmoidf_(float x) { return frcp(1.f + fexp(-x)); }

__host__ __device__ __forceinline__ int win_row(int n) {
    if (n < 1024 || n >= 2048) return n;
    const int s = (n - 1024) / 512, c = (n - 1024) % 512, head = c / 64, dim = c % 64;
    const int pn = 4 + 2 * s + head / 4, wc = head % 4, bj = dim / 32, w = dim % 32;
    return 256 * pn + 128 * bj + 32 * wc + w;
}
__host__ __device__ __forceinline__ void win_row_inv(int row, int& s, int& head, int& dim) {
    const int pn = row / 256, tl = row % 256, bj = tl / 128, wc = (tl % 128) / 32, w = tl % 32;
    s = (pn - 4) / 2; head = ((pn - 4) & 1) * 4 + wc; dim = 32 * bj + w;
}
__host__ __device__ __forceinline__ int gu_row(int j, int up) { return (j / 128) * 256 + up * 128 + (j % 128); }

typedef short s16x4_t __attribute__((ext_vector_type(4)));
__device__ __forceinline__ unsigned cvtpk_bf16(float lo, float hi) { unsigned r; asm volatile("v_cvt_pk_bf16_f32 %0, %1, %2" : "=v"(r) : "v"(lo), "v"(hi)); return r; }
template <class RowMap>
__device__ __forceinline__ void transpose_item(const float* W, int N, int k0, int n0, const float* gain, bf16* WT, int Kdst, RowMap rm, LAS unsigned char* tile, int lane) {
    const int kr = lane >> 4, c4 = lane & 15;
    f32x4 v[16]; float g[16];
#pragma unroll
    for (int i = 0; i < 16; ++i) { v[i] = __builtin_nontemporal_load((const f32x4*)(W + (size_t)(k0 + 4 * i + kr) * N + n0 + 4 * c4)); g[i] = gain ? gain[k0 + 4 * i + kr] : 1.f; }
#pragma unroll
    for (int i = 0; i < 16; ++i) { const f32x4 t = v[i] * g[i]; u32x2 w; w.x = cvtpk_bf16(t[0], t[1]); w.y = cvtpk_bf16(t[2], t[3]); *(LAS u32x2*)(tile + (4 * i + kr) * 192 + c4 * 8) = w; }
    asm volatile("s_waitcnt lgkmcnt(0)" ::: "memory");
    const LAS unsigned char* rp = tile + ((lane & 15) >> 2) * 192 + (lane >> 4) * 32 + (lane & 3) * 8;
    bf16x8 o[8];
#pragma unroll
    for (int c = 0; c < 8; ++c) {
        const s16x4_t a = __builtin_bit_cast(s16x4_t, __builtin_amdgcn_ds_read_tr16_b64_v4i16((LAS s16x4_t*)(rp + (8 * c) * 192)));
        const s16x4_t b = __builtin_bit_cast(s16x4_t, __builtin_amdgcn_ds_read_tr16_b64_v4i16((LAS s16x4_t*)(rp + (8 * c + 4) * 192)));
        o[c] = (bf16x8){a[0], a[1], a[2], a[3], b[0], b[1], b[2], b[3]};
    }
    asm volatile("s_waitcnt lgkmcnt(0)" ::: "memory");
#pragma unroll
    for (int c = 0; c < 8; ++c) *(LAS bf16x8*)(tile + lane * 144 + c * 16) = o[c];
    asm volatile("s_waitcnt lgkmcnt(0)" ::: "memory");
#pragma unroll
    for (int j = 0; j < 8; ++j) { const int n = 8 * j + (lane >> 3);
        const bf16x8 r = *(const LAS bf16x8*)(tile + n * 144 + (lane & 7) * 16);
        *(bf16x8*)(WT + (size_t)rm(n0 + n) * Kdst + k0 + 8 * (lane & 7)) = r; }
    asm volatile("s_waitcnt lgkmcnt(0)" ::: "memory");
}
__host__ __device__ __forceinline__ int adj_row(int n) { const int c = n & 255; return (n & ~255) + ((c >> 5) & 1) * 128 + (c >> 6) * 32 + (c & 31); }
struct RmId { __device__ int operator()(int n) const { return adj_row(n); } };
struct RmWin { __device__ int operator()(int n) const { return adj_row(n); } };
struct RmDown { __device__ int operator()(int n) const { const int c = n & 255, wc = c >> 6, rest = c & 63; return (n & ~255) + ((rest >> 3) & 1) * 128 + wc * 32 + (rest >> 4) * 8 + (rest & 7); } };
struct RmGu { int up; __device__ int operator()(int n) const { return gu_row(n, up); } };

constexpr int CV_WIN = 16 * 40, CV_WOUT = 16 * 16, CV_G = 16 * 8, CV_D = 8 * 16, CV_LAYER = CV_WIN + CV_WOUT + NE * (2 * CV_G + CV_D);
__device__ __forceinline__ void convert_items(const Ctx& c, int l, int lo, int hi, int widx, int nworkers) {
    LAS unsigned char* scr = c.lds + c.wave * 16384; unsigned char* ws = wsl(c); const int lane = c.lane;
    for (int it = lo + widx; it < hi; it += nworkers) {
        int r = it;
        if (r < CV_WIN) { const int kb = r / 40, nb = r % 40;
            transpose_item(inp(c, 2) + (size_t)l * D * DIN, DIN, 64 * kb, 64 * nb, inp(c, 1) + l * D, (bf16*)(ws + WS_WIN) + (size_t)l * DIN * D, D, RmWin{}, scr, lane); continue; }
        r -= CV_WIN;
        if (r < CV_WOUT) { const int kb = r / 16, nb = r % 16;
            transpose_item(inp(c, 14) + (size_t)l * D * D, D, 64 * kb, 64 * nb, nullptr, (bf16*)(ws + WS_WOUT) + (size_t)l * D * D, D, RmId{}, scr, lane); continue; }
        r -= CV_WOUT;
        const int e = r / (2 * CV_G + CV_D); r %= (2 * CV_G + CV_D);
        bf16* gu = (bf16*)(ws + WS_WGU) + ((size_t)l * NE + e) * 1024 * 1024;
        if (r < CV_G) { const int kb = r / 8, nb = r % 8;
            transpose_item(inp(c, 20) + ((size_t)l * NE + e) * D * DE, DE, 64 * kb, 64 * nb, inp(c, 15) + l * D, gu, D, RmGu{0}, scr, lane); continue; }
        r -= CV_G;
        if (r < CV_G) { const int kb = r / 8, nb = r % 8;
            transpose_item(inp(c, 21) + ((size_t)l * NE + e) * D * DE, DE, 64 * kb, 64 * nb, inp(c, 15) + l * D, gu, D, RmGu{1}, scr, lane); continue; }
        r -= CV_G;
        { const int kb = r / 16, nb = r % 16;
            transpose_item(inp(c, 22) + ((size_t)l * NE + e) * DE * D, D, 64 * kb, 64 * nb, nullptr, (bf16*)(ws + WS_WD) + ((size_t)l * NE + e) * D * DE, DE, RmDown{}, scr, lane); }
    }
}
#ifndef CV_AHEAD
#define CV_AHEAD 1
#endif
#ifndef CV_Q1
#define CV_Q1 56
#endif
#ifndef CV_Q2
#define CV_Q2 32
#endif
__device__ __forceinline__ void convert_ahead(const Ctx& c0, int which, int nunits) {
    const Ctx c = fresh(c0);
    if (!CV_AHEAD || c.l + 1 >= DEPTH) return;
    __syncthreads();
    const int rem = nunits % c.G, nspare = rem ? c.G - rem : 0;
    const int q1 = min(CV_LAYER, CV_Q1 * nspare), q2 = min(CV_LAYER, q1 + CV_Q2 * nspare);
    if (nspare && c.bid >= rem) { const int rank = c.bid - rem; convert_items(c, c.l + 1, which ? q1 : 0, which ? q2 : q1, rank * NWAVES + c.wave, nspare * NWAVES); }
    if (which) convert_items(c, c.l + 1, q2, CV_LAYER, c.gw, c.NGW);
}
__device__ __forceinline__ void p0_prologue(const Ctx& c0) {
    const Ctx c = fresh(c0);
    const int gw = c.gw, NGW = c.NGW, lane = c.lane;
    unsigned char* ws = wsl(c);
    if (CV_AHEAD) convert_items(c, 0, 0, CV_WIN + CV_WOUT, gw, NGW);
    else for (int l = 0; l < DEPTH; ++l) convert_items(c, l, 0, CV_LAYER, gw, NGW);
    const int gt = gw * 64 + lane, NGT = NGW * 64;
    for (int i = gt; i < DEPTH * 48 * 1024; i += NGT) {
        const int l = i / (48 * 1024), col = (i / 1024) % 48, k = i % 1024;
        float w = 0.f;
        if (col < 32) w = inp(c, 18)[((size_t)l * D + k) * 32 + col]; else if (col < 36) w = inp(c, 16)[((size_t)l * D + k) * 4 + (col - 32)];
        w *= inp(c, 15)[l * D + k];
        const unsigned hi = f2bf(w); const float res = w - bf2f(hi);
        bf16* wr = (bf16*)(ws + WS_WR) + (size_t)l * 2 * 48 * 1024;
        wr[col * 1024 + k] = (bf16)hi; wr[48 * 1024 + col * 1024 + k] = (bf16)f2bf(res);
    }
    for (int which = 0; which < 2; ++which) {
        const float* srcw = inp(c, which ? 7 : 5);
        for (int j = gt; j < DEPTH * 8 * 4096; j += NGT) {
            const int l = j / (8 * 4096), h = (j / 4096) % 8, n = (j / 64) % 64, k = j % 64;
            ((bf16*)(ws + WS_LRUW))[(((size_t)l * 2 + which) * 8 + h) * 4096 + n * 64 + k] = (bf16)f2bf(srcw[((size_t)l * 8 + h) * 4096 + k * 64 + n]);
        }
    }
    for (int i = gt; i < DEPTH * 512; i += NGT) { const float lam = inp(c, 9)[i]; ((float*)(ws + WS_SP))[i] = log1pf(__expf(-lam)); }
    for (int m = gw; m < T; m += NGW) {
        const f32x4* xr = (const f32x4*)(inp(c, 0) + (size_t)m * D) + lane;
        u32x2* xb = (u32x2*)((bf16*)(ws + WS_XB) + (size_t)m * D) + lane;
        float s = 0.f;
#pragma unroll
        for (int j = 0; j < 4; ++j) { const f32x4 v = xr[64 * j]; s += (v.x * v.x + v.y * v.y) + (v.z * v.z + v.w * v.w); u32x2 w; w.x = pk2(v.x, v.y); w.y = pk2(v.z, v.w); xb[64 * j] = w; }
        s = wave_sum(s, lane);
        if (lane == 0) ((float*)(ws + WS_RSTD1))[m] = 1.f / sqrtf(s * (1.f / D) + EPS);
    }
}

#define XB_TMO      128
#define XB_XCNT(j)  (256  + 64 * (j))
#define XB_XSUB(j)  (1280 + 64 * (j))
#define XB_XGEN(j)  (2304 + 64 * (j))
#define XB_TOP      3328
#define XB_TOPGEN   3392
#define XCD_BAR_WORDS 3456
#define XB_SPIN_CAP (1u << 18)
__device__ __forceinline__ unsigned xb_ld(unsigned* p)              { return __hip_atomic_load(p, __ATOMIC_RELAXED, __HIP_MEMORY_SCOPE_AGENT); }
__device__ __forceinline__ unsigned xb_add(unsigned* p, unsigned v) { return __hip_atomic_fetch_add(p, v, __ATOMIC_RELAXED, __HIP_MEMORY_SCOPE_AGENT); }
__device__ __forceinline__ unsigned xb_xcc_id() { return (unsigned)__builtin_amdgcn_s_getreg((3 << 11) | 20) & 0xFu; }
#define XB_SPIN(cond, bar) do { unsigned _sp = 0; while (cond) { __builtin_amdgcn_s_sleep(1); \
    if ((++_sp & 255u) == 0u) { if (xb_ld(&(bar)[XB_TMO])) break; if (_sp > XB_SPIN_CAP) { atomicAdd(&(bar)[XB_TMO], 1u); break; } } } } while (0)
struct XcdBarrier { unsigned* bar; unsigned x; volatile LAS unsigned* st; };
__device__ __forceinline__ XcdBarrier xcd_barrier_post(unsigned* bar, volatile LAS unsigned* st) {
    XcdBarrier b; b.bar = bar; b.x = xb_xcc_id(); b.st = st;
    if (threadIdx.x == 0) (void)xb_add(&bar[XB_XCNT(b.x)], 1u);
    return b;
}
__device__ __forceinline__ void xcd_barrier_complete(unsigned* bar, unsigned x, unsigned& nloc, unsigned& nx) {
    const unsigned G = gridDim.x * gridDim.y * gridDim.z;
    unsigned sum, cnt, mine, sp = 0u;
    for (;;) {
        sum = 0u; cnt = 0u; mine = 0u;
#pragma unroll
        for (unsigned j = 0; j < 16; ++j) { const unsigned c = xb_ld(&bar[XB_XCNT(j)]); sum += c; cnt += (c > 0u) ? 1u : 0u; mine = (j == x) ? c : mine; }
        if (sum == G) break;
        __builtin_amdgcn_s_sleep(1);
        if ((++sp & 255u) == 0u) { if (xb_ld(&bar[XB_TMO])) break; if (sp > XB_SPIN_CAP) { atomicAdd(&bar[XB_TMO], 1u); break; } }
    }
    nloc = mine > 0u ? mine : 1u; nx = cnt > 0u ? cnt : 1u;
}
__device__ __forceinline__ void xcd_barrier(const XcdBarrier& b) {
    asm volatile("s_waitcnt vmcnt(0)" ::: "memory");
    __syncthreads();
    if (threadIdx.x == 0) {
        unsigned* bar = b.bar;
        __builtin_amdgcn_s_waitcnt(0);
        unsigned nloc = b.st[0], nx = b.st[1];
        if (nloc == 0u) { xcd_barrier_complete(bar, b.x, nloc, nx); b.st[0] = nloc; b.st[1] = nx; }
        const unsigned old = xb_add(&bar[XB_XSUB(b.x)], 1u);
        const unsigned gen = old / nloc;
        if (old + 1u == (gen + 1u) * nloc) {
            __builtin_amdgcn_fence(__ATOMIC_RELEASE, "agent");
            asm volatile("s_waitcnt vmcnt(0)" ::: "memory");
            const unsigned og = xb_add(&bar[XB_TOP], 1u);
            const unsigned tg = og / nx;
            if (og + 1u == (tg + 1u) * nx) xb_add(&bar[XB_TOPGEN], 1u);
            else XB_SPIN(xb_ld(&bar[XB_TOPGEN]) == tg, bar);
            __builtin_amdgcn_fence(__ATOMIC_ACQUIRE, "agent");
            xb_add(&bar[XB_XGEN(b.x)], 1u);
            asm volatile("s_waitcnt vmcnt(0)" ::: "memory");
        } else {
            XB_SPIN(xb_ld(&bar[XB_XGEN(b.x)]) == gen, bar);
            __builtin_amdgcn_fence(__ATOMIC_ACQUIRE, "agent");
            asm volatile("s_waitcnt vmcnt(0)" ::: "memory");
        }
    }
    __syncthreads();
}

struct LV {
    const bf16 *win, *wout, *wgu, *wd, *wr, *wat, *wxt; const float* sp; unsigned* counts;
    bf16 *xb, *xl, *gg, *q, *k, *v, *obr, *hl, *pc, *merged, *hid, *ys;
    float *lbr, *aggA, *aggH, *carry, *rstd1, *rstd2, *tmp, *asg_w, *x, *rsl; int *asg_e, *asg_pos, *list;
};
__device__ __forceinline__ LV make_lv(const Ctx& c) {
    LV v; const int l = c.l; unsigned char* ws = wsl(c); unsigned char* act = ws + WS_ACT;
    v.win = (const bf16*)(ws + WS_WIN) + (size_t)l * DIN * D; v.wout = (const bf16*)(ws + WS_WOUT) + (size_t)l * D * D;
    v.wgu = (const bf16*)(ws + WS_WGU) + (size_t)l * NE * 1024 * 1024; v.wd = (const bf16*)(ws + WS_WD) + (size_t)l * NE * 1024 * 512;
    v.wr = (const bf16*)(ws + WS_WR) + (size_t)l * 2 * 48 * 1024; v.wat = (const bf16*)(ws + WS_LRUW) + (size_t)l * 2 * 8 * 4096; v.wxt = v.wat + 8 * 4096;
    v.sp = (const float*)(ws + WS_SP) + l * 512; v.counts = (unsigned*)(ws + WS_CTL) + CW_CNT + 64 * l;
    v.xb = (bf16*)(ws + WS_XB); v.xl = (bf16*)(act + A_XL); v.gg = (bf16*)(act + A_GG); v.q = (bf16*)(act + A_Q); v.k = (bf16*)(act + A_K); v.v = (bf16*)(act + A_V);
    v.obr = (bf16*)(act + A_OBR); v.hl = (bf16*)(act + A_HL); v.pc = (bf16*)(act + A_PC); v.merged = (bf16*)(act + A_MERGED); v.hid = (bf16*)(act + A_HID); v.ys = (bf16*)(act + A_YS);
    v.lbr = (float*)(act + A_LBR); v.aggA = (float*)(act + A_AGG); v.aggH = v.aggA + NB * NCHUNK * 512; v.carry = v.aggH + NB * NCHUNK * 512;
    v.rstd1 = (float*)(ws + WS_RSTD1); v.rstd2 = (float*)(ws + WS_RSTD2); v.tmp = (float*)(ws + WS_TMP);
    v.asg_e = (int*)(ws + WS_ASG); v.asg_pos = v.asg_e + 2 * T; v.asg_w = (float*)(v.asg_pos + 2 * T); v.list = (int*)(ws + WS_LIST); v.x = c.out; v.rsl = (float*)(ws + WS_TMP + 64 * MiB);
    return v;
}

template <class Epi>
__device__ __forceinline__ void n_gemm(const Ctx& c0, const bf16* A, const bf16* Bt, int M, int N, int K, const Epi& epi) {
    const Ctx c = fresh(c0);
    const int lane = c.lane, r16 = lane & 15, q4 = lane >> 4, tn_n = N / 64, ntile = (M / 64) * tn_n;
    for (int wv = c.gw; wv < ntile; wv += c.NGW) {
        const int tm = wv / tn_n, tn = wv % tn_n;
        f32x4 acc[4][4];
#pragma unroll
        for (int i = 0; i < 4; ++i)
#pragma unroll
            for (int j = 0; j < 4; ++j) acc[i][j] = (f32x4){0.f, 0.f, 0.f, 0.f};
        for (int k0 = 0; k0 < K; k0 += 32) {
            bf16x8 a[4], b[4];
#pragma unroll
            for (int i = 0; i < 4; ++i) { a[i] = *(const bf16x8*)(A + (size_t)(tm * 64 + i * 16 + r16) * K + k0 + 8 * q4); b[i] = *(const bf16x8*)(Bt + (size_t)(tn * 64 + i * 16 + r16) * K + k0 + 8 * q4); }
#pragma unroll
            for (int i = 0; i < 4; ++i)
#pragma unroll
                for (int j = 0; j < 4; ++j) acc[i][j] = __builtin_amdgcn_mfma_f32_16x16x32_bf16(a[i], b[j], acc[i][j], 0, 0, 0);
        }
#pragma unroll
        for (int i = 0; i < 4; ++i)
#pragma unroll
            for (int j = 0; j < 4; ++j)
#pragma unroll
                for (int r = 0; r < 4; ++r) epi(tm * 64 + i * 16 + 4 * q4 + r, tn * 64 + j * 16 + r16, acc[i][j][r]);
    }
}
struct EpiProjN {
    const float* rstd; bf16 *xl, *gg, *v; float* qk;
    __device__ void operator()(int row, int n, float a) const {
        const float val = a * rstd[row];
        if (n < 512) xl[(size_t)row * 512 + n] = (bf16)f2bf(val);
        else if (n < 1024) gg[(size_t)row * 512 + n - 512] = (bf16)f2bf(gelu_tanh(val));
        else if (n < 2048) { int s, head, dim; win_row_inv(n, s, head, dim); qk[(size_t)row * 1024 + s * 512 + head * 64 + dim] = val; }
        else v[(size_t)row * 512 + n - 2048] = (bf16)f2bf(val);
    }
};
struct EpiOutN { float* x; bf16* xb; __device__ void operator()(int row, int n, float a) const { const size_t i = (size_t)row * 1024 + n; xb[i] = (bf16)f2bf(bf2f(xb[i]) + a); } };

__device__ __forceinline__ void n_qknorm(const Ctx& c0) {
    const Ctx c = fresh(c0); const LV v = make_lv(c);
    const float* qg = inp(c, 10) + c.l * 64; const float* kg = inp(c, 11) + c.l * 64;
    for (int i = c.gt; i < T * 16; i += c.NGT) {
        const int row = i / 16, s = (i / 8) % 2, head = i % 8;
        const float* src = v.tmp + (size_t)row * 1024 + s * 512 + head * 64;
        float ss = 0.f; for (int d = 0; d < 64; ++d) ss += src[d] * src[d];
        const float r = 1.f / sqrtf(ss * (1.f / 64.f) + EPS);
        bf16* dst = (s ? v.k : v.q) + (size_t)row * 512 + head * 64;
        for (int d = 0; d < 64; ++d) dst[d] = (bf16)f2bf(src[d] * r * (s ? kg[d] : qg[d] * QSCALE));
    }
}
__device__ __forceinline__ void n_attn(const Ctx& c0) {
    const Ctx c = fresh(c0); const LV v = make_lv(c);
    for (int i = c.gt; i < T * 8; i += c.NGT) {
        const int t = i / 8, h = i % 8, b = t / SEQ, pos = t % SEQ;
        float qf[64];
        { const bf16* qp = v.q + (size_t)t * 512 + h * 64;
#pragma unroll
          for (int d = 0; d < 64; ++d) qf[d] = bf2f(qp[d]); }
        for (int br = 0; br < 3; ++br) {
            const int dil = br == 0 ? 1 : (br == 1 ? 4 : 16);
            float o[64];
#pragma unroll
            for (int d = 0; d < 64; ++d) o[d] = 0.f;
            float l = 0.f;
            for (int m = 0; m <= 128; ++m) {
                const int kp = pos - m * dil; if (kp < 0) break;
                const size_t off = ((size_t)b * SEQ + kp) * 512 + h * 64;
                float s = 0.f;
#pragma unroll
                for (int d8 = 0; d8 < 8; ++d8) { const bf16x8 kv = *(const bf16x8*)(v.k + off + d8 * 8);
#pragma unroll
                    for (int j = 0; j < 8; ++j) s += qf[d8 * 8 + j] * bf2f((unsigned short)kv[j]); }
                const float pw = exp2f(s); l += pw;
#pragma unroll
                for (int d8 = 0; d8 < 8; ++d8) { const bf16x8 vv = *(const bf16x8*)(v.v + off + d8 * 8);
#pragma unroll
                    for (int j = 0; j < 8; ++j) o[d8 * 8 + j] += pw * bf2f((unsigned short)vv[j]); }
            }
            const float rl = 1.f / l;
            bf16* op = v.obr + (size_t)br * T * 512 + (size_t)t * 512 + h * 64;
#pragma unroll
            for (int d = 0; d < 64; ++d) op[d] = (bf16)f2bf(o[d] * rl);
            v.lbr[(size_t)br * T * 8 + (size_t)t * 8 + h] = l;
        }
    }
}
__device__ __forceinline__ void n_lru_au(const Ctx& c0) {
    const Ctx c = fresh(c0); const LV v = make_lv(c);
    const int l = c.l; const float* cw = inp(c, 3) + l * 4 * 512; const float* cb = inp(c, 4) + l * 512; const float* ba = inp(c, 6) + l * 512; const float* bx = inp(c, 8) + l * 512;
    float* a_out = v.tmp; float* u_out = v.tmp + (size_t)T * 512;
    for (int i = c.gt; i < T * 512; i += c.NGT) {
        const int t = i / 512, ch0 = i % 512, pos = t % SEQ, h = ch0 / 64, n = ch0 % 64;
        float ra = 0.f, rx = 0.f, xc_own = 0.f;
        for (int kk = 0; kk < 64; ++kk) {
            const int ch = h * 64 + kk; float xc = cb[ch];
            for (int j = 0; j < 4; ++j) { const int pp = pos - 3 + j; if (pp >= 0) xc += cw[j * 512 + ch] * bf2f(v.xl[(size_t)(t - 3 + j) * 512 + ch]); }
            if (kk == n) xc_own = xc;
            const float xcb = bf2f(f2bf(xc));
            ra += xcb * bf2f(v.wat[(h * 64 + n) * 64 + kk]); rx += xcb * bf2f(v.wxt[(h * 64 + n) * 64 + kk]);
        }
        const float r = sigmoidf_(ra + ba[ch0]), ig = sigmoidf_(rx + bx[ch0]);
        const float log_a = -8.f * r * v.sp[ch0];
        const float a = __expf(log_a);
        a_out[i] = a; u_out[i] = sqrtf(fmaxf(1.f - a * a, 0.f)) * (ig * xc_own);
    }
}
__device__ __forceinline__ void n_lru_scan(const Ctx& c0) {
    const Ctx c = fresh(c0); const LV v = make_lv(c);
    const float* a_in = v.tmp; const float* u_in = v.tmp + (size_t)T * 512;
    for (int i = c.gt; i < NB * NCHUNK * 512; i += c.NGT) {
        const int ch = i % 512, bc = i / 512;
        float h = 0.f, P = 1.f;
        for (int j = 0; j < 32; ++j) { const size_t idx = ((size_t)bc * 32 + j) * 512 + ch; const float a = a_in[idx]; h = a * h + u_in[idx]; P *= a; v.hl[idx] = (bf16)f2bf(h); v.pc[idx] = (bf16)f2bf(P); }
        v.aggA[i] = P; v.aggH[i] = h;
    }
}
__device__ __forceinline__ void n_lru_carry(const Ctx& c0) {
    const Ctx c = fresh(c0); const LV v = make_lv(c);
    for (int i = c.gt; i < NB * 512; i += c.NGT) {
        const int b = i / 512, ch = i % 512; float h = 0.f;
        for (int k = 0; k < NCHUNK; ++k) { const size_t idx = ((size_t)b * NCHUNK + k) * 512 + ch; v.carry[idx] = h; h = v.aggA[idx] * h + v.aggH[idx]; }
    }
}
__device__ __forceinline__ void n_merge(const Ctx& c0) {
    const Ctx c = fresh(c0); const LV v = make_lv(c);
    const float* gl = inp(c, 12) + c.l * 512; const float* ga = inp(c, 13) + c.l * 512; const int lane = c.lane;
    for (int t = c.gw; t < T; t += c.NGW) {
        float yl[8], ya[8]; float s1 = 0.f, s2 = 0.f;
#pragma unroll
        for (int j = 0; j < 8; ++j) { const int ch = c.lane + 64 * j; const size_t idx = (size_t)t * 512 + ch;
            const float h = bf2f(v.hl[idx]) + bf2f(v.pc[idx]) * v.carry[(size_t)(t / 32) * 512 + ch];
            yl[j] = h * bf2f(v.gg[idx]); s1 += yl[j] * yl[j];
            const int hd = ch / 64; float num = 0.f, den = 0.f;
#pragma unroll
            for (int br = 0; br < 3; ++br) { const float l = v.lbr[(size_t)br * T * 8 + (size_t)t * 8 + hd]; num += l * bf2f(v.obr[(size_t)br * T * 512 + idx]); den += l; }
            ya[j] = num / den; s2 += ya[j] * ya[j]; }
        s1 = wave_sum(s1, lane); s2 = wave_sum(s2, lane);
        const float r1 = 1.f / sqrtf(s1 * (1.f / 512.f) + EPS), r2 = 1.f / sqrtf(s2 * (1.f / 512.f) + EPS);
#pragma unroll
        for (int j = 0; j < 8; ++j) { const int ch = c.lane + 64 * j;
            v.merged[(size_t)t * 1024 + ch] = (bf16)f2bf(yl[j] * r1 * gl[ch]); v.merged[(size_t)t * 1024 + 512 + ch] = (bf16)f2bf(ya[j] * r2 * ga[ch]); }
    }
}
__device__ __forceinline__ void n_router(const Ctx& c0) {
    const Ctx c = fresh(c0); const LV v = make_lv(c);
    const float* bg = inp(c, 17) + c.l * 4; const float* be = inp(c, 19) + c.l * 32;
    LAS float* lg = (LAS float*)(c.lds + LDS_MISC + 1024 + c.wave * 256);
    const int lane = c.lane;
    for (int t = c.gw; t < T; t += c.NGW) {
        const bf16* xr = v.xb + (size_t)t * 1024;
        float xv[16]; float ss = 0.f;
#pragma unroll
        for (int j = 0; j < 16; ++j) { xv[j] = bf2f(xr[lane + 64 * j]); ss += xv[j] * xv[j]; }
        ss = wave_sum(ss, lane); const float rs = 1.f / sqrtf(ss * (1.f / 1024.f) + EPS);
        for (int col = 0; col < 36; ++col) { float s = 0.f;
#pragma unroll
            for (int j = 0; j < 16; ++j) { const int k = lane + 64 * j; s += xv[j] * (bf2f(v.wr[col * 1024 + k]) + bf2f(v.wr[48 * 1024 + col * 1024 + k])); }
            s = wave_sum(s, lane) * rs + (col < 32 ? be[col] : bg[col - 32]); if (lane == 0) lg[col] = s; }
        asm volatile("s_waitcnt lgkmcnt(0)" ::: "memory");
        if (lane == 0) {
            v.rstd2[t] = rs;
            int g = 0; float gm = lg[32]; for (int j = 1; j < 4; ++j) if (lg[32 + j] > gm) { gm = lg[32 + j]; g = j; }
            float den = 0.f; for (int j = 0; j < 4; ++j) den += __expf(lg[32 + j] - gm);
            const float ptop = 1.f / den;
            int i1 = 0; float v1 = lg[g * 8]; for (int j = 1; j < 8; ++j) if (lg[g * 8 + j] > v1) { v1 = lg[g * 8 + j]; i1 = j; }
            int i2 = -1; float v2 = -INFINITY; for (int j = 0; j < 8; ++j) if (j != i1 && lg[g * 8 + j] > v2) { v2 = lg[g * 8 + j]; i2 = j; }
            const float e2 = __expf(v2 - v1), w1 = ptop / (1.f + e2), w2 = ptop * e2 / (1.f + e2);
            const int ea = g * 8 + i1, eb = g * 8 + i2;
            const int pa = (int)atomicAdd(&v.counts[ea], 1u), pb = (int)atomicAdd(&v.counts[eb], 1u);
            v.asg_e[2 * t] = ea; v.asg_pos[2 * t] = pa; v.asg_w[2 * t] = w1; v.list[(size_t)ea * T + pa] = 2 * t;
            v.asg_e[2 * t + 1] = eb; v.asg_pos[2 * t + 1] = pb; v.asg_w[2 * t + 1] = w2; v.list[(size_t)eb * T + pb] = 2 * t + 1;
        }
        asm volatile("s_waitcnt lgkmcnt(0)" ::: "memory");
    }
}
__device__ __forceinline__ LAS int* moe_plan(const Ctx& c, const unsigned* counts) {
    LAS int* tstart = (LAS int*)(c.lds + LDS_MISC);
    __syncthreads();
    if (c.tid < 64) {
        const int e = c.tid & 31;
        const int cn = (int)__hip_atomic_load(&counts[e], __ATOMIC_RELAXED, __HIP_MEMORY_SCOPE_AGENT);
        const int tiles = (cn + 255) / 256; int incl = tiles;
#pragma unroll
        for (int o = 1; o < 32; o <<= 1) { const int up = __builtin_amdgcn_ds_bpermute(((c.tid - o) & 63) << 2, incl); if (e >= o) incl += up; }
        if (c.tid < 32) { tstart[e] = incl - tiles; tstart[40 + e] = cn; if (e == 31) tstart[NE] = incl; }
    }
    __syncthreads();
    return tstart;
}
__device__ __forceinline__ void n_moe_up(const Ctx& c0) {
    const Ctx c = fresh(c0); const LV v = make_lv(c);
    LAS int* tstart = moe_plan(c, v.counts);
    const int lane = c.lane, r16 = lane & 15, q4 = lane >> 4, NT = tstart[NE];
    for (int wv = c.gw; wv < NT * 4 * 16; wv += c.NGW) {
        const int rt64 = wv / 16, jb = wv % 16, rt = rt64 / 4;
        int e = 0; while (tstart[e + 1] <= rt) ++e;
        const int cnt = tstart[40 + e], pos0 = (rt - tstart[e]) * 256 + (rt64 % 4) * 64;
        if (pos0 >= cnt) continue;
        const bf16* W = v.wgu + (size_t)e * 1024 * 1024;
        int tok[4];
#pragma unroll
        for (int i = 0; i < 4; ++i) { int pos = pos0 + i * 16 + r16; if (pos >= cnt) pos = pos0; tok[i] = v.list[(size_t)e * T + pos] >> 1; }
        f32x4 ag[4][2], au[4][2];
#pragma unroll
        for (int i = 0; i < 4; ++i)
#pragma unroll
            for (int j = 0; j < 2; ++j) { ag[i][j] = (f32x4){0.f, 0.f, 0.f, 0.f}; au[i][j] = (f32x4){0.f, 0.f, 0.f, 0.f}; }
        for (int k0 = 0; k0 < 1024; k0 += 32) {
            bf16x8 a[4], bg_[2], bu_[2];
#pragma unroll
            for (int i = 0; i < 4; ++i) a[i] = *(const bf16x8*)(v.xb + (size_t)tok[i] * 1024 + k0 + 8 * q4);
#pragma unroll
            for (int j = 0; j < 2; ++j) { const int col = jb * 32 + j * 16 + r16; bg_[j] = *(const bf16x8*)(W + (size_t)gu_row(col, 0) * 1024 + k0 + 8 * q4); bu_[j] = *(const bf16x8*)(W + (size_t)gu_row(col, 1) * 1024 + k0 + 8 * q4); }
#pragma unroll
            for (int i = 0; i < 4; ++i)
#pragma unroll
                for (int j = 0; j < 2; ++j) { ag[i][j] = __builtin_amdgcn_mfma_f32_16x16x32_bf16(a[i], bg_[j], ag[i][j], 0, 0, 0); au[i][j] = __builtin_amdgcn_mfma_f32_16x16x32_bf16(a[i], bu_[j], au[i][j], 0, 0, 0); }
        }
#pragma unroll
        for (int i = 0; i < 4; ++i)
#pragma unroll
            for (int r = 0; r < 4; ++r) { const int pos = pos0 + i * 16 + 4 * q4 + r; if (pos >= cnt) continue;
                const int tk = v.list[(size_t)e * T + pos] >> 1; const float rs = v.rstd2[tk];
#pragma unroll
                for (int j = 0; j < 2; ++j) { const float g = ag[i][j][r] * rs, u = au[i][j][r] * rs; const float hv = g * sigmoidf_(g) * u;
                    v.hid[(size_t)(tstart[e] * 256 + pos) * 512 + jb * 32 + j * 16 + r16] = (bf16)f2bf(hv); } }
    }
}
__device__ __forceinline__ void n_moe_down(const Ctx& c0) {
    const Ctx c = fresh(c0); const LV v = make_lv(c);
    LAS int* tstart = moe_plan(c, v.counts);
    const int lane = c.lane, r16 = lane & 15, q4 = lane >> 4, NT = tstart[NE];
    for (int wv = c.gw; wv < NT * 4 * 16; wv += c.NGW) {
        const int rt64 = wv / 16, nb = wv % 16, rt = rt64 / 4;
        int e = 0; while (tstart[e + 1] <= rt) ++e;
        const int cnt = tstart[40 + e], pos0 = (rt - tstart[e]) * 256 + (rt64 % 4) * 64;
        if (pos0 >= cnt) continue;
        const bf16* W = v.wd + (size_t)e * 1024 * 512;
        const size_t rowbase = (size_t)tstart[e] * 256;
        f32x4 acc[4][4];
#pragma unroll
        for (int i = 0; i < 4; ++i)
#pragma unroll
            for (int j = 0; j < 4; ++j) acc[i][j] = (f32x4){0.f, 0.f, 0.f, 0.f};
        for (int k0 = 0; k0 < 512; k0 += 32) {
            bf16x8 a[4], b[4];
#pragma unroll
            for (int i = 0; i < 4; ++i) { int pos = pos0 + i * 16 + r16; if (pos >= cnt) pos = pos0; a[i] = *(const bf16x8*)(v.hid + (rowbase + pos) * 512 + k0 + 8 * q4); b[i] = *(const bf16x8*)(W + (size_t)(nb * 64 + i * 16 + r16) * 512 + k0 + 8 * q4); }
#pragma unroll
            for (int i = 0; i < 4; ++i)
#pragma unroll
                for (int j = 0; j < 4; ++j) acc[i][j] = __builtin_amdgcn_mfma_f32_16x16x32_bf16(a[i], b[j], acc[i][j], 0, 0, 0);
        }
#pragma unroll
        for (int i = 0; i < 4; ++i)
#pragma unroll
            for (int r = 0; r < 4; ++r) { const int pos = pos0 + i * 16 + 4 * q4 + r; if (pos >= cnt) continue;
#pragma unroll
                for (int j = 0; j < 4; ++j) v.ys[(rowbase + pos) * 1024 + nb * 64 + j * 16 + r16] = (bf16)f2bf(acc[i][j][r]); }
    }
}
__device__ __forceinline__ void n_combine(const Ctx& c0) {
    const Ctx c = fresh(c0); const LV v = make_lv(c);
    LAS int* tstart = moe_plan(c, v.counts); const int lane = c.lane;
    for (int t = c.gw; t < T; t += c.NGW) {
        const size_t r0 = (size_t)tstart[v.asg_e[2 * t]] * 256 + v.asg_pos[2 * t], r1 = (size_t)tstart[v.asg_e[2 * t + 1]] * 256 + v.asg_pos[2 * t + 1];
        float s = 0.f;
#pragma unroll
        for (int j = 0; j < 16; ++j) { const int col = c.lane + 64 * j; const size_t i = (size_t)t * 1024 + col;
            const float val = bf2f(v.xb[i]) + v.asg_w[2 * t] * bf2f(v.ys[r0 * 1024 + col]) + v.asg_w[2 * t + 1] * bf2f(v.ys[r1 * 1024 + col]); if (c.l == DEPTH - 1) v.x[i] = val; else v.xb[i] = (bf16)f2bf(val); s += val * val; }
        s = wave_sum(s, lane);
        if (c.lane == 0) v.rstd1[t] = 1.f / sqrtf(s * (1.f / 1024.f) + EPS);
    }
}

namespace pg8 {
constexpr int BM = 256, BK = 64, HALF = 128, HTB = HALF * BK * 2, STAGE_BYTES = 8 * HTB, NXCD = 8, WGM = 8;
__device__ __forceinline__ int lds_byte(int r, int c) { const int st = (r >> 4) * 2 + (c >> 5), rr = r & 15, cc = c & 31, ob = rr * 64 + cc * 2; return st * 1024 + (ob ^ (((ob >> 9) & 1) << 5)); }
__device__ __forceinline__ void stage_rc(int b, int& R, int& C) { const int st = b / 1024, sb = b % 1024, swz = sb ^ (((sb >> 9) & 1) << 5); R = (st >> 1) * 16 + swz / 64; C = (st & 1) * 32 + (swz % 64) / 2; }
__device__ __forceinline__ int perm32(int rho) { const int n = rho >> 4, i = rho & 15; return 8 * (i >> 2) + 4 * n + (i & 3); }
struct Unit { int pm, pn, e, pos0, cnt; };
__device__ __forceinline__ unsigned cvt_pk_bf16(float lo, float hi) { unsigned r; asm volatile("v_cvt_pk_bf16_f32 %0, %1, %2" : "=v"(r) : "v"(lo), "v"(hi)); return r; }

__device__ __forceinline__ bool order_next(int i, int G, int c, int nM, int nN, int& pm, int& pn) {
    const int nwg = nM * nN; const long L = (long)i * G + c; if (L >= nwg) return false;
    int wgid = (int)L; { const int q = nwg / NXCD, r = nwg % NXCD, xcd = wgid % NXCD, off = wgid / NXCD; wgid = (xcd < r ? xcd * (q + 1) : r * (q + 1) + (xcd - r) * q) + off; }
    const int nig = WGM * nN, gid = wgid / nig, fm = gid * WGM, gsz = (nM - fm) < WGM ? (nM - fm) : WGM;
    pm = fm + ((wgid % nig) % gsz); pn = (wgid % nig) / gsz; return true;
}
struct DenseSched {
    static constexpr bool GATHER = false;
    const char* A; const char* Bt; int nM, nN, K, G, c;
    __device__ __forceinline__ bool next(int i, Unit& u) const { u.e = 0; u.pos0 = 0; u.cnt = 0; return order_next(i, G, c, nM, nN, u.pm, u.pn); }
    __device__ __forceinline__ const char* abase(const Unit& u) const { return A + (size_t)u.pm * 256 * K * 2; }
    __device__ __forceinline__ const char* bbase(const Unit& u) const { return Bt + (size_t)u.pn * 256 * K * 2; }
    __device__ __forceinline__ void aoff(const Unit&, unsigned (&)[2][2], const int (&)[2], const int (&)[2]) const {}
};
template <bool GATHER_> struct MoeSched {
    static constexpr bool GATHER = GATHER_;
    const char* A; const char* W; const int* list; const unsigned* counts; LAS int* tstart; int K, G, c;
    __device__ __forceinline__ bool next(int i, Unit& u) const {
        const int NT = __builtin_amdgcn_readfirstlane(tstart[NE]);
        if (!order_next(i, G, c, NT, 4, u.pm, u.pn)) return false;
        int e = 0; while (__builtin_amdgcn_readfirstlane(tstart[e + 1]) <= u.pm) ++e;
        u.e = e; u.pos0 = (u.pm - __builtin_amdgcn_readfirstlane(tstart[e])) * 256; u.cnt = __builtin_amdgcn_readfirstlane(tstart[40 + e]); return true;
    }
    __device__ __forceinline__ const char* abase(const Unit& u) const { return GATHER ? A : A + (size_t)u.pm * 256 * K * 2; }
    __device__ __forceinline__ const char* bbase(const Unit& u) const { return W + ((size_t)u.e * 1024 + (size_t)u.pn * 256) * K * 2; }
    __device__ __forceinline__ void aoff(const Unit& u, unsigned (&ao)[2][2], const int (&R)[2], const int (&C)[2]) const {
#pragma unroll
        for (int h = 0; h < 2; ++h)
#pragma unroll
            for (int i = 0; i < 2; ++i) { int pos = u.pos0 + h * 128 + R[i]; if (pos >= u.cnt) pos = u.pos0; const int tok = list[(size_t)u.e * T + pos] >> 1; ao[h][i] = (unsigned)(tok * 1024 + C[i]) * 2u; }
    }
};

template <class Epi, class Sched>
__device__ __forceinline__ void gemm_phase(LAS unsigned char* lds, const Sched& S, const Epi& E) {
    int tid = threadIdx.x; asm volatile("" : "+v"(tid));
    const int wid = __builtin_amdgcn_readfirstlane(tid >> 6), lane = tid & 63, wr = wid >> 2, wc = wid & 3, fr = lane & 15, fq = lane >> 4;
    const int K = S.K, nt = K / BK;
    constexpr bool GATHER = Sched::GATHER;
    int Rr[2], Cc[2]; unsigned voffA[2], voffB[2];
#pragma unroll
    for (int i = 0; i < 2; ++i) { int R, C; stage_rc(tid * 16 + i * 8192, R, C); const int Rb = Epi::PERM ? ((R & ~31) + perm32(R & 31)) : R; Rr[i] = R; Cc[i] = C; voffA[i] = (unsigned)(R * K + C) * 2u; voffB[i] = (unsigned)(Rb * K + C) * 2u; }
    const size_t kstep = (size_t)(BK * 2);
    const size_t hstep = (size_t)HALF * K * 2;
    const unsigned ldsw = (unsigned)wid * 1024u;
    const int aoff_l = lds_byte(wr * 64 + fr, fq * 8), boff_l = lds_byte(wc * 32 + fr, fq * 8);
#define PG8_SA(b, h) (((b) * 2 + (h)) * HTB)
#define PG8_SB(b, h) ((4 + (b) * 2 + (h)) * HTB)
#define PG8_STAGE_B(bufoff, gbase) do { _Pragma("unroll") for (int _i = 0; _i < 2; ++_i) \
        __builtin_amdgcn_global_load_lds((const unsigned*)((const char*)(gbase) + voffB[_i]), (LAS unsigned*)(lds + (bufoff) + ldsw + _i * 8192), 16, 0, 0); } while (0)
#define PG8_STAGE_A(bufoff, gbase, h, AO) do { _Pragma("unroll") for (int _i = 0; _i < 2; ++_i) \
        __builtin_amdgcn_global_load_lds((const unsigned*)(GATHER ? (const char*)(gbase) + (AO)[h][_i] : (const char*)(gbase) + (h) * hstep + voffA[_i]), (LAS unsigned*)(lds + (bufoff) + ldsw + _i * 8192), 16, 0, 0); } while (0)
#define PG8_LDA(dst, b, h) do { _Pragma("unroll") for (int m = 0; m < 4; ++m) _Pragma("unroll") for (int k = 0; k < 2; ++k) dst[m][k] = *(const LAS bf16x8*)(lds + PG8_SA(b, h) + aoff_l + m * 2048 + k * 1024); } while (0)
#define PG8_LDB(dst, b, h) do { _Pragma("unroll") for (int n = 0; n < 2; ++n) _Pragma("unroll") for (int k = 0; k < 2; ++k) dst[n][k] = *(const LAS bf16x8*)(lds + PG8_SB(b, h) + boff_l + n * 2048 + k * 1024); } while (0)
#define PG8_MMA(ai, bj, At, Bt) do { __builtin_amdgcn_s_setprio(1); _Pragma("unroll") for (int m = 0; m < 4; ++m) _Pragma("unroll") for (int n = 0; n < 2; ++n) _Pragma("unroll") for (int k = 0; k < 2; ++k) \
        acc[ai][bj][m][n] = __builtin_amdgcn_mfma_f32_16x16x32_bf16(Bt[n][k], At[m][k], acc[ai][bj][m][n], 0, 0, 0); __builtin_amdgcn_s_setprio(0); } while (0)
#define PG8_WAIT_V(n) asm volatile("s_waitcnt vmcnt(" #n ")" ::: "memory")
#define PG8_WAIT_L(n) asm volatile("s_waitcnt lgkmcnt(" #n ")" ::: "memory")
#define PG8_BAR __builtin_amdgcn_s_barrier()
#define PG8_SCHED __builtin_amdgcn_sched_barrier(0)
    Unit cur, nxt; int ui = 0;
    if (!S.next(0, cur)) return;
    f32x4 acc[2][2][4][2];
#pragma unroll
    for (int a = 0; a < 2; ++a)
#pragma unroll
        for (int b = 0; b < 2; ++b)
#pragma unroll
            for (int m = 0; m < 4; ++m)
#pragma unroll
                for (int n = 0; n < 2; ++n) acc[a][b][m][n] = (f32x4){0.f, 0.f, 0.f, 0.f};
    bf16x8 At[4][2], B0[2][2], B1[2][2];
    unsigned aoC[2][2], aoN[2][2];
    if constexpr (GATHER) S.aoff(cur, aoC, Rr, Cc);
    const char* cA = S.abase(cur);
    const char* cB = S.bbase(cur);
    PG8_STAGE_B(PG8_SB(0, 0), cB); PG8_STAGE_B(PG8_SB(0, 1), cB + hstep); PG8_STAGE_A(PG8_SA(0, 0), cA, 0, aoC); PG8_STAGE_A(PG8_SA(0, 1), cA, 1, aoC);
    if (wr == 1) PG8_BAR;
    PG8_WAIT_V(2); PG8_BAR;
    PG8_STAGE_B(PG8_SB(1, 0), cB + kstep); PG8_STAGE_A(PG8_SA(1, 0), cA + kstep, 0, aoC); PG8_STAGE_B(PG8_SB(1, 1), cB + hstep + kstep);
    PG8_WAIT_V(6); PG8_BAR;
    for (;;) {
        const bool has_next = S.next(ui + 1, nxt);
        const char* nA = has_next ? S.abase(nxt) : cA; const char* nB = has_next ? S.bbase(nxt) : cB;
        if constexpr (GATHER) {
            if (has_next) S.aoff(nxt, aoN, Rr, Cc);
            else {
#pragma unroll
                for (int h = 0; h < 2; ++h)
#pragma unroll
                    for (int i = 0; i < 2; ++i) aoN[h][i] = aoC[h][i];
            }
        }
        for (int t = 0; t < nt; t += 2) {
            const bool last = (t == nt - 2);
            const char* a1 = cA + (size_t)(t + 1) * kstep;
            const char* a2 = last ? nA : cA + (size_t)(t + 2) * kstep; const char* b2 = last ? nB : cB + (size_t)(t + 2) * kstep;
            const char* a3 = a2 + kstep; const char* b3 = b2 + kstep;
            unsigned ao2[2][2];
            if constexpr (GATHER) {
#pragma unroll
                for (int h = 0; h < 2; ++h)
#pragma unroll
                    for (int i = 0; i < 2; ++i) ao2[h][i] = last ? aoN[h][i] : aoC[h][i];
            }
            PG8_LDB(B0, 0, 0); PG8_LDB(B1, 0, 1); PG8_SCHED; PG8_LDA(At, 0, 0); PG8_STAGE_A(PG8_SA(1, 1), a1, 1, aoC);
            PG8_WAIT_V(8); PG8_WAIT_L(0); PG8_BAR; PG8_MMA(0, 0, At, B0); PG8_MMA(0, 1, At, B1); PG8_BAR; PG8_SCHED;
            PG8_LDA(At, 0, 1); PG8_STAGE_B(PG8_SB(0, 0), b2); PG8_STAGE_B(PG8_SB(0, 1), b2 + hstep); PG8_STAGE_A(PG8_SA(0, 0), a2, 0, ao2);
            PG8_WAIT_V(8); PG8_WAIT_L(0); PG8_BAR; PG8_MMA(1, 0, At, B0); PG8_MMA(1, 1, At, B1); PG8_BAR; PG8_SCHED;
            PG8_LDB(B0, 1, 0); PG8_LDB(B1, 1, 1); PG8_SCHED; PG8_LDA(At, 1, 0); PG8_STAGE_A(PG8_SA(0, 1), a2, 1, ao2);
            PG8_WAIT_V(8); PG8_WAIT_L(0); PG8_BAR; PG8_MMA(0, 0, At, B0); PG8_MMA(0, 1, At, B1); PG8_BAR; PG8_SCHED;
            PG8_LDA(At, 1, 1); PG8_STAGE_B(PG8_SB(1, 0), b3); PG8_STAGE_B(PG8_SB(1, 1), b3 + hstep); PG8_STAGE_A(PG8_SA(1, 0), a3, 0, ao2);
            PG8_WAIT_V(8); PG8_WAIT_L(0); PG8_BAR; PG8_MMA(1, 0, At, B0); PG8_MMA(1, 1, At, B1); PG8_BAR; PG8_SCHED;
        }
        if (wr == 0) PG8_BAR;
        E(acc, cur, wr, wc, fr, fq);
        if (!has_next) break;
#pragma unroll
        for (int a = 0; a < 2; ++a)
#pragma unroll
            for (int b = 0; b < 2; ++b)
#pragma unroll
                for (int m = 0; m < 4; ++m)
#pragma unroll
                    for (int n = 0; n < 2; ++n) acc[a][b][m][n] = (f32x4){0.f, 0.f, 0.f, 0.f};
        cur = nxt; cA = nA; cB = nB; ++ui;
        if constexpr (GATHER) {
#pragma unroll
            for (int h = 0; h < 2; ++h)
#pragma unroll
                for (int i = 0; i < 2; ++i) aoC[h][i] = aoN[h][i];
        }
        if (wr == 1) PG8_BAR;
    }
    PG8_WAIT_V(0);
    PG8_BAR;
#undef PG8_SA
#undef PG8_SB
#undef PG8_STAGE_A
#undef PG8_STAGE_B
#undef PG8_LDA
#undef PG8_LDB
#undef PG8_MMA
#undef PG8_WAIT_V
#undef PG8_WAIT_L
#undef PG8_BAR
#undef PG8_SCHED
}

__device__ __forceinline__ unsigned ror8(unsigned v) { return (unsigned)__builtin_amdgcn_update_dpp(0, (int)v, 0x128, 0xF, 0xF, false); }
__device__ __forceinline__ void store_patch(bf16* p, size_t pitch, u32x4 w0, u32x4 w1, int fr, int fq) {
    const bool lo = fr < 8;
    u32x4 r; r.x = ror8(lo ? w1.x : w0.x); r.y = ror8(lo ? w1.y : w0.y); r.z = ror8(lo ? w1.z : w0.z); r.w = ror8(lo ? w1.w : w0.w);
    u32x4 d1, d2; d1.x = lo ? w0.x : r.x; d1.y = lo ? w0.y : r.y; d1.z = lo ? w0.z : r.z; d1.w = lo ? w0.w : r.w;
    d2.x = lo ? r.x : w1.x; d2.y = lo ? r.y : w1.y; d2.z = lo ? r.z : w1.z; d2.w = lo ? r.w : w1.w;
    bf16* q = p + (size_t)(fr & 7) * pitch + (lo ? 0 : 32) + 8 * fq;
    *(u32x4*)q = d1; *(u32x4*)(q + 8 * pitch) = d2;
}
struct EpiProj {
    static constexpr bool PERM = true;
    const float* rstd; bf16* base5;
    const float *qg, *kg;
    __device__ __forceinline__ void operator()(const f32x4 (&acc)[2][2][4][2], const Unit& u_, int wr, int wc, int fr_, int fq_) const {
        int fr = fr_, fq = fq_; asm volatile("" : "+v"(fr), "+v"(fq));
        Unit u = u_; asm volatile("" : "+s"(u.pm), "+s"(u.pn)); const int lane = fq * 16 + fr;
        const int sec = u.pn >> 1, half = u.pn & 1, row0 = u.pm * BM + wr * 64;
        bf16* dstp = base5 + (size_t)sec * ((size_t)T * 512) + half * 256 + wc * 64;
        if (sec == 2 || sec == 3) {
            const float* gp = sec == 2 ? qg : kg; const float sc = sec == 2 ? QSCALE : 1.f;
            f32x4 g[2][2];
#pragma unroll
            for (int bj = 0; bj < 2; ++bj)
#pragma unroll
                for (int n = 0; n < 2; ++n) g[bj][n] = *(const f32x4*)(gp + 32 * bj + 8 * fq + 4 * n) * sc;
#pragma unroll
            for (int ai = 0; ai < 2; ++ai)
#pragma unroll
                for (int m = 0; m < 4; ++m) { const int rowb = row0 + ai * HALF + m * 16; const float rs = rstd[rowb + fr];
                    f32x4 val[2][2]; float ss = 0.f;
#pragma unroll
                    for (int bj = 0; bj < 2; ++bj)
#pragma unroll
                        for (int n = 0; n < 2; ++n) { const f32x4 t = acc[ai][bj][m][n] * rs; val[bj][n] = t; ss += (t[0] * t[0] + t[1] * t[1]) + (t[2] * t[2] + t[3] * t[3]); }
                    ss += shx(ss, lane, 16); ss += shx(ss, lane, 32);
                    const float r = frsq(ss * (1.f / 64.f) + EPS);
                    u32x4 w[2];
#pragma unroll
                    for (int bj = 0; bj < 2; ++bj) { const f32x4 v0 = val[bj][0] * r * g[bj][0], v1 = val[bj][1] * r * g[bj][1];
                        w[bj].x = cvt_pk_bf16(v0[0], v0[1]); w[bj].y = cvt_pk_bf16(v0[2], v0[3]); w[bj].z = cvt_pk_bf16(v1[0], v1[1]); w[bj].w = cvt_pk_bf16(v1[2], v1[3]); }
                    store_patch(dstp + (size_t)rowb * 512, 512, w[0], w[1], fr, fq); }
        } else {
#pragma unroll
            for (int ai = 0; ai < 2; ++ai)
#pragma unroll
                for (int m = 0; m < 4; ++m) { const int rowb = row0 + ai * HALF + m * 16; const float rs = rstd[rowb + fr];
                    u32x4 w[2];
#pragma unroll
                    for (int bj = 0; bj < 2; ++bj) { f32x4 v0 = acc[ai][bj][m][0] * rs, v1 = acc[ai][bj][m][1] * rs;
                        if (sec == 1) { v0 = (f32x4){gelu_tanh(v0[0]), gelu_tanh(v0[1]), gelu_tanh(v0[2]), gelu_tanh(v0[3])}; v1 = (f32x4){gelu_tanh(v1[0]), gelu_tanh(v1[1]), gelu_tanh(v1[2]), gelu_tanh(v1[3])}; }
                        w[bj].x = cvt_pk_bf16(v0[0], v0[1]); w[bj].y = cvt_pk_bf16(v0[2], v0[3]); w[bj].z = cvt_pk_bf16(v1[0], v1[1]); w[bj].w = cvt_pk_bf16(v1[2], v1[3]); }
                    store_patch(dstp + (size_t)rowb * 512, 512, w[0], w[1], fr, fq); }
        }
    }
};
struct EpiOut {
    static constexpr bool PERM = true;
    const bf16* xi; bf16* xo;
    __device__ __forceinline__ void operator()(const f32x4 (&acc)[2][2][4][2], const Unit& u_, int wr, int wc, int fr_, int fq_) const {
        int fr = fr_, fq = fq_; asm volatile("" : "+v"(fr), "+v"(fq));
        Unit u = u_; asm volatile("" : "+s"(u.pm), "+s"(u.pn));
        const int colp = u.pn * BM + wc * 64;
        const bool lo = fr < 8; const size_t lanecol = (size_t)colp + (lo ? 0 : 32) + 8 * fq;
#pragma unroll
        for (int ai = 0; ai < 2; ++ai)
#pragma unroll
            for (int m = 0; m < 4; ++m) { const size_t rowb = (size_t)(u.pm * BM + ai * HALF + wr * 64 + m * 16);
                const bf16* q = xi + (rowb + (fr & 7)) * 1024 + lanecol;
                const u32x4 old1 = *(const u32x4*)q, old2 = *(const u32x4*)(q + 8 * 1024);
                float e1[8], e2[8];
#pragma unroll
                for (int n = 0; n < 2; ++n)
#pragma unroll
                    for (int i = 0; i < 4; ++i) { const float a0 = acc[ai][0][m][n][i], a1 = acc[ai][1][m][n][i];
                        const float r = __builtin_bit_cast(float, ror8(__builtin_bit_cast(unsigned, lo ? a1 : a0)));
                        e1[4 * n + i] = lo ? a0 : r; e2[4 * n + i] = lo ? r : a1; }
                u32x4 d1, d2;
                d1.x = cvt_pk_bf16(bf2f(old1.x & 0xffffu) + e1[0], bf2f(old1.x >> 16) + e1[1]); d1.y = cvt_pk_bf16(bf2f(old1.y & 0xffffu) + e1[2], bf2f(old1.y >> 16) + e1[3]);
                d1.z = cvt_pk_bf16(bf2f(old1.z & 0xffffu) + e1[4], bf2f(old1.z >> 16) + e1[5]); d1.w = cvt_pk_bf16(bf2f(old1.w & 0xffffu) + e1[6], bf2f(old1.w >> 16) + e1[7]);
                d2.x = cvt_pk_bf16(bf2f(old2.x & 0xffffu) + e2[0], bf2f(old2.x >> 16) + e2[1]); d2.y = cvt_pk_bf16(bf2f(old2.y & 0xffffu) + e2[2], bf2f(old2.y >> 16) + e2[3]);
                d2.z = cvt_pk_bf16(bf2f(old2.z & 0xffffu) + e2[4], bf2f(old2.z >> 16) + e2[5]); d2.w = cvt_pk_bf16(bf2f(old2.w & 0xffffu) + e2[6], bf2f(old2.w >> 16) + e2[7]);
                bf16* qo = xo + (rowb + (fr & 7)) * 1024 + lanecol;
                *(u32x4*)qo = d1; *(u32x4*)(qo + 8 * 1024) = d2; }
    }
};
struct EpiUp {
    static constexpr bool PERM = true;
    const float* rsl; bf16* hid;
    __device__ __forceinline__ void operator()(const f32x4 (&acc)[2][2][4][2], const Unit& u_, int wr, int wc, int fr_, int fq_) const {
        int fr = fr_, fq = fq_; asm volatile("" : "+v"(fr), "+v"(fq));
        Unit u = u_; asm volatile("" : "+s"(u.pos0), "+s"(u.pm));
        bf16* dst = hid + (size_t)(u.pm * BM) * 512 + u.pn * 128 + wc * 32 + 8 * fq;
#pragma unroll
        for (int ai = 0; ai < 2; ++ai)
#pragma unroll
            for (int m = 0; m < 4; ++m) { const int rl = ai * HALF + wr * 64 + m * 16 + fr; int pos = u.pos0 + rl; if (pos >= u.cnt) pos = u.pos0;
                const float rs = rsl[(size_t)u.e * T + pos];
                float h[8];
#pragma unroll
                for (int n = 0; n < 2; ++n)
#pragma unroll
                    for (int i = 0; i < 4; ++i) { const float g = acc[ai][0][m][n][i] * rs, up = acc[ai][1][m][n][i] * rs; h[4 * n + i] = g * up * frcp(1.f + fexp(-g)); }
                u32x4 w; w.x = cvt_pk_bf16(h[0], h[1]); w.y = cvt_pk_bf16(h[2], h[3]); w.z = cvt_pk_bf16(h[4], h[5]); w.w = cvt_pk_bf16(h[6], h[7]);
                *(u32x4*)(dst + (size_t)rl * 512) = w; }
    }
};
constexpr float YS_SCALE = 16.f;
__device__ __forceinline__ float sat8(float x) { return __builtin_amdgcn_fmed3f(x, -448.f, 448.f); }
__device__ __forceinline__ unsigned pk4_fp8(float a, float b, float c2, float d) { a = sat8(a); b = sat8(b); c2 = sat8(c2); d = sat8(d); int w = 0; w = __builtin_amdgcn_cvt_pk_fp8_f32(a, b, w, false); w = __builtin_amdgcn_cvt_pk_fp8_f32(c2, d, w, true); return (unsigned)w; }
struct EpiDown {
    static constexpr bool PERM = true;
    unsigned char* ys;
    __device__ __forceinline__ void operator()(const f32x4 (&acc)[2][2][4][2], const Unit& u_, int wr, int wc, int fr_, int fq_) const {
        int fr = fr_, fq = fq_; asm volatile("" : "+v"(fr), "+v"(fq));
        Unit u = u_; asm volatile("" : "+s"(u.pos0), "+s"(u.pm));
        unsigned char* dst = ys + (size_t)(u.pm * BM + wr * 64 + fr) * 1024 + u.pn * BM + wc * 64 + 16 * fq;
#pragma unroll
        for (int ai = 0; ai < 2; ++ai)
#pragma unroll
            for (int m = 0; m < 4; ++m) { const int rl = ai * HALF + m * 16;
                const f32x4 a0 = acc[ai][0][m][0] * YS_SCALE, a1 = acc[ai][0][m][1] * YS_SCALE, b0 = acc[ai][1][m][0] * YS_SCALE, b1 = acc[ai][1][m][1] * YS_SCALE;
                u32x4 w; w.x = pk4_fp8(a0[0], a0[1], a0[2], a0[3]); w.y = pk4_fp8(a1[0], a1[1], a1[2], a1[3]); w.z = pk4_fp8(b0[0], b0[1], b0[2], b0[3]); w.w = pk4_fp8(b1[0], b1[1], b1[2], b1[3]);
                *(u32x4*)(dst + (size_t)rl * 1024) = w; }
    }
};
}

namespace attn {
typedef float f32x16 __attribute__((ext_vector_type(16)));
typedef short s16x4 __attribute__((ext_vector_type(4)));
constexpr int KSTR = 6160;
constexpr int LK = 0, LVV = 8 * KSTR, VSTR = 24576, LO = LVV + 2 * VSTR;
static_assert(LO + 8 * 4096 <= LDS_MISC, "attention LDS map");
__device__ __forceinline__ int crow(int r, int hi) { return (r & 3) + 8 * (r >> 2) + 4 * hi; }
__device__ __forceinline__ s16x4 vtr(const LAS unsigned char* p) { return __builtin_bit_cast(s16x4, __builtin_amdgcn_ds_read_tr16_b64_v4i16((LAS s16x4*)p)); }
__device__ __forceinline__ unsigned cvtpk(float lo, float hi) { unsigned r; asm volatile("v_cvt_pk_bf16_f32 %0, %1, %2" : "=v"(r) : "v"(lo), "v"(hi)); return r; }

__device__ __forceinline__ void phase(const Ctx& c0) {
    const Ctx c = fresh(c0); const LV v = make_lv(c);
    const int lane = c.lane, w = c.wave, r32 = lane & 31, hi = lane >> 5;
    LAS unsigned char* lds = c.lds;
    u32x4 kreg[6], vreg[6]; bf16x8 qr[4];
#define ATT_DECODE(U_) const int b = (U_) / 384, rem = (U_) % 384, h = rem / 48, rem2 = rem % 48, br = rem2 >> 4, u16 = rem2 & 15; \
        const int dsh = 2 * br, d = 1 << dsh, r = u16 & (d - 1), nb = u16 >> dsh; const int i0 = 256 * nb - 128; const size_t tokbase = (size_t)b * SEQ;
#define ATT_LOAD(U_) do { ATT_DECODE(U_) const bf16* kg = v.k + h * 64; const bf16* vg = v.v + h * 64; \
        _Pragma("unroll") for (int j = 0; j < 6; ++j) { const int p = c.tid + 512 * j, row = p >> 3, ch = p & 7, idx = i0 + row; \
            const size_t tok = tokbase + (size_t)(idx < 0 ? 0 : idx) * d + r; kreg[j] = *(const u32x4*)(kg + tok * 512 + ch * 8); vreg[j] = *(const u32x4*)(vg + tok * 512 + ch * 8); } \
        _Pragma("unroll") for (int s2 = 0; s2 < 4; ++s2) { const size_t qtok = tokbase + (size_t)(256 * nb + 32 * w + (lane >> 3) + 8 * s2) * d + r;     \
            qr[s2] = *(const bf16x8*)(v.q + qtok * 512 + h * 64 + (lane & 7) * 8); } } while (0)
    const int vid = (c.G % 8 == 0) ? (c.bid % 8) * (c.G / 8) + c.bid / 8 : c.bid;
    constexpr int NUNIT = NB * NHEAD * 3 * 16;
    const bool xmap = (c.G == 256); const int xj = c.bid >> 3, xx = c.bid & 7;
    const int upw = xmap ? NUNIT / 256 : (vid < NUNIT ? (NUNIT - vid + c.G - 1) / c.G : 0);
#define ATT_UID(i_) (xmap ? (((xx * 4 + (i_) / 3) * 2 + (xj >> 4)) * 48 + ((i_) % 3) * 16 + (xj & 15)) : vid + c.G * (i_))
    if (upw > 0) ATT_LOAD(ATT_UID(0));
    for (int iu = 0; iu < upw; ++iu) {
        const int U = ATT_UID(iu);
        ATT_DECODE(U)
#pragma unroll
        for (int j = 0; j < 6; ++j) { const int p = c.tid + 512 * j, row = p >> 3, ch = p & 7;
            *(LAS u32x4*)(lds + LK + ch * KSTR + row * 16) = kreg[j];
            *(LAS u32x4*)(lds + LVV + (ch >> 2) * VSTR + (row >> 4) * 1024 + (row & 15) * 64 + (ch & 3) * 16) = vreg[j]; }
        bf16x8 qc[4];
        { LAS unsigned char* qst = lds + LO + w * 4096;
#pragma unroll
          for (int j = 0; j < 4; ++j) { const int row = (lane >> 3) + 8 * j; *(LAS bf16x8*)(qst + row * 128 + (((lane & 7) ^ (row & 7)) * 16)) = qr[j]; }
          asm volatile("s_waitcnt lgkmcnt(0)" ::: "memory");
#pragma unroll
          for (int s2 = 0; s2 < 4; ++s2) qc[s2] = *(const LAS bf16x8*)(qst + r32 * 128 + (((2 * s2 + hi) ^ (r32 & 7)) * 16));
          asm volatile("s_waitcnt lgkmcnt(0)" ::: "memory"); }
        if (iu + 1 < upw) ATT_LOAD(ATT_UID(iu + 1));
        __syncthreads();
        f32x16 o0 = {}, o1 = {}; float lsum = 0.f;
        const LAS unsigned char* vbase = lds + LVV + ((lane >> 4) & 1) * 32 + (lane & 3) * 8 + (4 * hi + ((lane & 15) >> 2)) * 64;
        for (int kt = 0; kt < 5; ++kt) {
            if (nb == 0 && w + kt < 4) continue;
            const int rr0 = 32 * (w + kt);
            f32x16 p = {};
#pragma unroll
            for (int s2 = 0; s2 < 4; ++s2) { const bf16x8 kf = *(const LAS bf16x8*)(lds + LK + (2 * s2 + hi) * KSTR + (rr0 + r32) * 16); p = __builtin_amdgcn_mfma_f32_32x32x16_bf16(kf, qc[s2], p, 0, 0, 0); }
#pragma unroll
            for (int rI = 0; rI < 16; ++rI) { const int kk = crow(rI, hi); float e = __builtin_amdgcn_exp2f(p[rI]);
                if (kt == 0 && kk < r32) e = 0.f; if (kt == 4 && kk > r32) e = 0.f; p[rI] = e; lsum += e; }
            u32x4 pw0, pw1;
            pw0.x = cvtpk(p[0], p[1]); pw0.y = cvtpk(p[2], p[3]); pw0.z = cvtpk(p[4], p[5]); pw0.w = cvtpk(p[6], p[7]);
            pw1.x = cvtpk(p[8], p[9]); pw1.y = cvtpk(p[10], p[11]); pw1.z = cvtpk(p[12], p[13]); pw1.w = cvtpk(p[14], p[15]);
            const bf16x8 pa0 = __builtin_bit_cast(bf16x8, pw0), pa1 = __builtin_bit_cast(bf16x8, pw1);
            const LAS unsigned char* vt = vbase + (rr0 >> 4) * 1024;
#pragma unroll
            for (int ks = 0; ks < 2; ++ks) {
                const s16x4 a0 = vtr(vt + ks * 1024), a1 = vtr(vt + ks * 1024 + 512), b0 = vtr(vt + VSTR + ks * 1024), b1 = vtr(vt + VSTR + ks * 1024 + 512);
                const bf16x8 vf0 = (bf16x8){a0[0], a0[1], a0[2], a0[3], a1[0], a1[1], a1[2], a1[3]}, vf1 = (bf16x8){b0[0], b0[1], b0[2], b0[3], b1[0], b1[1], b1[2], b1[3]};
                o0 = __builtin_amdgcn_mfma_f32_32x32x16_bf16(ks ? pa1 : pa0, vf0, o0, 0, 0, 0);
                o1 = __builtin_amdgcn_mfma_f32_32x32x16_bf16(ks ? pa1 : pa0, vf1, o1, 0, 0, 0);
            }
        }
        lsum += shx(lsum, lane, 32);
        LAS bf16* stg = (LAS bf16*)(lds + LO + w * 4096);
#pragma unroll
        for (int rI = 0; rI < 16; ++rI) { const int orow = crow(rI, hi);
            const float rl = frcp(__builtin_bit_cast(float, __builtin_amdgcn_ds_bpermute(orow << 2, __builtin_bit_cast(int, lsum))));
            stg[orow * 64 + r32] = (bf16)f2bf(o0[rI] * rl); stg[orow * 64 + 32 + r32] = (bf16)f2bf(o1[rI] * rl); }
        asm volatile("s_waitcnt lgkmcnt(0)" ::: "memory");
        bf16* ob = v.obr + (size_t)br * T * 512 + h * 64;
#pragma unroll
        for (int i = 0; i < 4; ++i) { const int row = i * 8 + (lane >> 3), ch = lane & 7; const u32x4 val = *(const LAS u32x4*)(stg + row * 64 + ch * 8);
            const size_t tok = tokbase + (size_t)(256 * nb + 32 * w + row) * d + r; *(u32x4*)(ob + tok * 512 + ch * 8) = val; }
        if (hi == 0) { const size_t tok = tokbase + (size_t)(256 * nb + 32 * w + r32) * d + r; v.lbr[(size_t)br * T * 8 + tok * 8 + h] = lsum; }
        __syncthreads();
    }
}
}

namespace lru {
typedef float f32x16 __attribute__((ext_vector_type(16)));
constexpr int L_CW = 0, L_CB = 8192, L_BA = 10240, L_BX = 12288, L_SP = 14336, L_SCR = 16384, SCR_STRIDE = 68, SCR_BYTES = 32 * SCR_STRIDE * 4;
constexpr int L_RAW = L_SCR + 8 * SCR_BYTES, RAW_STRIDE = 144, RAW_BYTES = 5120;
static_assert(L_RAW + 8 * RAW_BYTES <= LDS_MISC && 35 * RAW_STRIDE <= RAW_BYTES, "lru LDS map");
__device__ __forceinline__ int crow(int r, int hi) { return (r & 3) + 8 * (r >> 2) + 4 * hi; }
__device__ __forceinline__ void phase(const Ctx& c0) {
    const Ctx c = fresh(c0); const LV v = make_lv(c);
    const int lane = c.lane, tok = lane & 31, hi = lane >> 5, l = c.l;
    LAS unsigned char* lds = c.lds;
    __syncthreads();
    { const float* cw = inp(c, 3) + l * 2048; const float* cb = inp(c, 4) + l * 512; const float* ba = inp(c, 6) + l * 512; const float* bx = inp(c, 8) + l * 512;
      for (int i = c.tid; i < 2048; i += NTHREADS) ((LAS float*)(lds + L_CW))[i] = cw[i];
      { const int i = c.tid; ((LAS float*)(lds + L_CB))[i] = cb[i]; ((LAS float*)(lds + L_BA))[i] = ba[i]; ((LAS float*)(lds + L_BX))[i] = bx[i]; ((LAS float*)(lds + L_SP))[i] = v.sp[i]; } }
    __syncthreads();
    LAS float* scr = (LAS float*)(lds + L_SCR + c.wave * SCR_BYTES);
    const int h = c.gw & 7;
    bf16x8 fa[4][2], fx[4][2];
#pragma unroll
    for (int s2 = 0; s2 < 4; ++s2)
#pragma unroll
        for (int nbk = 0; nbk < 2; ++nbk) { const size_t wo = (size_t)(h * 64 + 32 * nbk + tok) * 64 + 16 * s2 + 8 * hi; fa[s2][nbk] = *(const bf16x8*)(v.wat + wo); fx[s2][nbk] = *(const bf16x8*)(v.wxt + wo); }
    LAS unsigned char* rawt = lds + L_RAW + c.wave * RAW_BYTES;
    u32x4 rreg[5];
#define LRU_LOAD(it_) do { const int bc_ = (it_) >> 3, t0_ = bc_ * 32, pos0_ = (bc_ & (NCHUNK - 1)) * 32; \
        _Pragma("unroll") for (int j = 0; j < 5; ++j) { const int p = lane + 64 * j, row = p >> 3, pc8 = p & 7; const bool ok = (row < 35) && (pos0_ + row - 3 >= 0); \
            const u32x4 val = *(const u32x4*)(v.xl + (size_t)(t0_ + (ok ? row - 3 : 0)) * 512 + h * 64 + pc8 * 8); rreg[j] = ok ? val : (u32x4){0u, 0u, 0u, 0u}; } } while (0)
    if (c.gw < NB * NCHUNK * 8) LRU_LOAD(c.gw);
    for (int it = c.gw; it < NB * NCHUNK * 8; it += c.NGW) {
        const int bc = it >> 3, t0 = bc * 32;
#pragma unroll
        for (int j = 0; j < 5; ++j) { const int p = lane + 64 * j, row = p >> 3, pc8 = p & 7; if (row < 35) *(LAS u32x4*)(rawt + row * RAW_STRIDE + pc8 * 16) = rreg[j]; }
        if (it + c.NGW < NB * NCHUNK * 8) LRU_LOAD(it + c.NGW);
        asm volatile("s_waitcnt lgkmcnt(0)" ::: "memory");
        bf16x8 axc[4];
#pragma unroll
        for (int s2 = 0; s2 < 4; ++s2) {
            const int ch0 = h * 64 + 16 * s2 + 8 * hi;
            f32x4 x0 = *(const LAS f32x4*)(lds + L_CB + ch0 * 4), x1 = *(const LAS f32x4*)(lds + L_CB + ch0 * 4 + 16);
#pragma unroll
            for (int tap = 0; tap < 4; ++tap) {
                const u32x4 raw = *(const LAS u32x4*)(rawt + (tok + tap) * RAW_STRIDE + (2 * s2 + hi) * 16);
                const f32x4 w0 = *(const LAS f32x4*)(lds + L_CW + (tap * 512 + ch0) * 4), w1 = *(const LAS f32x4*)(lds + L_CW + (tap * 512 + ch0) * 4 + 16);
                x0[0] += w0[0] * bf2f(raw.x & 0xffffu); x0[1] += w0[1] * bf2f(raw.x >> 16); x0[2] += w0[2] * bf2f(raw.y & 0xffffu); x0[3] += w0[3] * bf2f(raw.y >> 16);
                x1[0] += w1[0] * bf2f(raw.z & 0xffffu); x1[1] += w1[1] * bf2f(raw.z >> 16); x1[2] += w1[2] * bf2f(raw.w & 0xffffu); x1[3] += w1[3] * bf2f(raw.w >> 16);
            }
            *(LAS f32x4*)(scr + tok * SCR_STRIDE + 16 * s2 + 8 * hi) = x0; *(LAS f32x4*)(scr + tok * SCR_STRIDE + 16 * s2 + 8 * hi + 4) = x1;
            u32x4 pk; pk.x = pk2(x0[0], x0[1]); pk.y = pk2(x0[2], x0[3]); pk.z = pk2(x1[0], x1[1]); pk.w = pk2(x1[2], x1[3]);
            axc[s2] = __builtin_bit_cast(bf16x8, pk);
        }
        f32x16 ra[2] = {{}, {}}, rx[2] = {{}, {}};
#pragma unroll
        for (int s2 = 0; s2 < 4; ++s2)
#pragma unroll
            for (int nbk = 0; nbk < 2; ++nbk) {
                ra[nbk] = __builtin_amdgcn_mfma_f32_32x32x16_bf16(axc[s2], fa[s2][nbk], ra[nbk], 0, 0, 0); rx[nbk] = __builtin_amdgcn_mfma_f32_32x32x16_bf16(axc[s2], fx[s2][nbk], rx[nbk], 0, 0, 0); }
#pragma unroll
        for (int nbk = 0; nbk < 2; ++nbk) {
            const int ch = h * 64 + 32 * nbk + tok;
            const float bav = ((const LAS float*)(lds + L_BA))[ch], bxv = ((const LAS float*)(lds + L_BX))[ch], spv = ((const LAS float*)(lds + L_SP))[ch];
            float hl_[16], pl_[16], Hg[4], Ag[4];
#pragma unroll
            for (int g = 0; g < 4; ++g) { float H = 0.f, P = 1.f;
#pragma unroll
                for (int i = 0; i < 4; ++i) { const int rI = 4 * g + i; const float xcv = scr[crow(rI, hi) * SCR_STRIDE + 32 * nbk + tok];
                    const float r = sigmoidf_(ra[nbk][rI] + bav), ig = sigmoidf_(rx[nbk][rI] + bxv);
                    const float a = fexp(-8.f * r * spv), u = fsqrt(fmaxf(1.f - a * a, 0.f)) * (ig * xcv);
                    H = a * H + u; P *= a; hl_[rI] = H; pl_[rI] = P; }
                Hg[g] = H; Ag[g] = P; }
            float ch_ = 0.f, cp_ = 1.f, oh = 0.f, op = 1.f;
#pragma unroll
            for (int g = 0; g < 4; ++g) {
                float in_h = ch_, in_p = cp_; oh = Ag[g] * in_h + Hg[g]; op = in_p * Ag[g];
                const float x_h = shx(oh, lane, 32), x_p = shx(op, lane, 32);
                if (hi) { in_h = x_h; in_p = x_p; oh = Ag[g] * in_h + Hg[g]; op = in_p * Ag[g]; }
                ch_ = shx(oh, lane, 32); cp_ = shx(op, lane, 32);
#pragma unroll
                for (int i = 0; i < 4; ++i) { const int rI = 4 * g + i;
                    ((LAS unsigned*)scr)[crow(rI, hi) * SCR_STRIDE + 32 * nbk + tok] = pk2(hl_[rI] + pl_[rI] * in_h, in_p * pl_[rI]); }
            }
            if (hi) { v.aggA[(size_t)bc * 512 + ch] = op; v.aggH[(size_t)bc * 512 + ch] = oh; }
        }
        asm volatile("s_waitcnt lgkmcnt(0)" ::: "memory");
#pragma unroll
        for (int j = 0; j < 4; ++j) { const int tk = 8 * j + (lane >> 3), c8 = (lane & 7) * 8;
            const u32x4 w0 = *(const LAS u32x4*)(scr + tk * SCR_STRIDE + c8), w1 = *(const LAS u32x4*)(scr + tk * SCR_STRIDE + c8 + 4);
            u32x4 hv, pv;
            hv.x = (w0.x & 0xffffu) | (w0.y << 16); hv.y = (w0.z & 0xffffu) | (w0.w << 16); hv.z = (w1.x & 0xffffu) | (w1.y << 16); hv.w = (w1.z & 0xffffu) | (w1.w << 16);
            pv.x = (w0.x >> 16) | (w0.y & 0xffff0000u); pv.y = (w0.z >> 16) | (w0.w & 0xffff0000u); pv.z = (w1.x >> 16) | (w1.y & 0xffff0000u); pv.w = (w1.z >> 16) | (w1.w & 0xffff0000u);
            const size_t o = (size_t)(t0 + tk) * 512 + h * 64 + c8;
            *(u32x4*)(v.hl + o) = hv; *(u32x4*)(v.pc + o) = pv; }
        asm volatile("s_waitcnt lgkmcnt(0)" ::: "memory");
    }
}
}

namespace mrg {
__device__ __forceinline__ void phase(const Ctx& c0) {
    const Ctx c = fresh(c0); const LV v = make_lv(c);
    const int lane = c.lane, w = c.wave;
    LAS float* cl = (LAS float*)c.lds;
    f32x4 gl0, gl1, ga0, ga1;
    { const float* gl = inp(c, 12) + c.l * 512 + lane * 8; const float* ga = inp(c, 13) + c.l * 512 + lane * 8; gl0 = *(const f32x4*)gl; gl1 = *(const f32x4*)(gl + 4); ga0 = *(const f32x4*)ga; ga1 = *(const f32x4*)(ga + 4); }
    for (int item = c.bid; item < T / 128; item += c.G) {
        const int b = item >> 5, chunk0 = (item & 31) * 4;
        __syncthreads();
        { const float* A0 = v.aggA + (size_t)b * NCHUNK * 512; const float* H0 = v.aggH + (size_t)b * NCHUNK * 512;
          LAS float* part = cl + 4 * 512;
          const int seg = (chunk0 + 7) >> 3, k0 = w * seg, k1 = min(k0 + seg, chunk0);
          float pa[8], ph[8];
#pragma unroll
          for (int j = 0; j < 8; ++j) { pa[j] = 1.f; ph[j] = 0.f; }
          for (int k = k0; k < k1; k += 8) { float a[8][8], h[8][8];
#pragma unroll
              for (int q = 0; q < 8; ++q) { const int kk = min(k + q, k1 - 1);
#pragma unroll
                  for (int j = 0; j < 8; ++j) { a[q][j] = A0[(size_t)kk * 512 + lane + 64 * j]; h[q][j] = H0[(size_t)kk * 512 + lane + 64 * j]; } }
#pragma unroll
              for (int q = 0; q < 8; ++q) if (k + q < k1) {
#pragma unroll
                  for (int j = 0; j < 8; ++j) { ph[j] = a[q][j] * ph[j] + h[q][j]; pa[j] *= a[q][j]; } } }
#pragma unroll
          for (int j = 0; j < 8; ++j) { part[(w * 512 + lane + 64 * j) * 2] = pa[j]; part[(w * 512 + lane + 64 * j) * 2 + 1] = ph[j]; }
          __syncthreads();
          float hc = 0.f;
#pragma unroll
          for (int q = 0; q < 8; ++q) hc = part[(q * 512 + c.tid) * 2] * hc + part[(q * 512 + c.tid) * 2 + 1];
          const float* A = A0 + c.tid; const float* H = H0 + c.tid;
          float a4[4], h4[4];
#pragma unroll
          for (int j = 0; j < 4; ++j) { a4[j] = A[(chunk0 + j) * 512]; h4[j] = H[(chunk0 + j) * 512]; }
#pragma unroll
          for (int j = 0; j < 4; ++j) { cl[j * 512 + c.tid] = hc; hc = a4[j] * hc + h4[j]; } }
        __syncthreads();
        const LAS float* cr = cl + (w >> 1) * 512 + lane * 8;
        const f32x4 c0v = *(const LAS f32x4*)cr, c1v = *(const LAS f32x4*)(cr + 4);
        const float cv[8] = {c0v[0], c0v[1], c0v[2], c0v[3], c1v[0], c1v[1], c1v[2], c1v[3]};
        for (int ib = 0; ib < 16; ib += 4) {
            u32x4 hl[4], pc[4], gg[4], o0[4], o1[4], o2[4]; float l0[4], l1[4], l2[4];
#pragma unroll
            for (int q = 0; q < 4; ++q) { const size_t t = (size_t)item * 128 + w * 16 + ib + q, o = t * 512 + lane * 8;
                hl[q] = __builtin_nontemporal_load((const u32x4*)(v.hl + o)); pc[q] = __builtin_nontemporal_load((const u32x4*)(v.pc + o)); gg[q] = __builtin_nontemporal_load((const u32x4*)(v.gg + o));
                o0[q] = __builtin_nontemporal_load((const u32x4*)(v.obr + o)); o1[q] = __builtin_nontemporal_load((const u32x4*)(v.obr + (size_t)T * 512 + o)); o2[q] = __builtin_nontemporal_load((const u32x4*)(v.obr + (size_t)2 * T * 512 + o));
                l0[q] = v.lbr[t * 8 + (lane >> 3)]; l1[q] = v.lbr[(size_t)T * 8 + t * 8 + (lane >> 3)]; l2[q] = v.lbr[(size_t)2 * T * 8 + t * 8 + (lane >> 3)]; }
#pragma unroll
            for (int q = 0; q < 4; ++q) { const size_t t = (size_t)item * 128 + w * 16 + ib + q;
                const float rden = frcp(l0[q] + l1[q] + l2[q]);
                float yl[8], ya[8]; float s1 = 0.f, s2 = 0.f;
#pragma unroll
                for (int j = 0; j < 8; ++j) { const unsigned sh = (j & 1) * 16;
                    const float hv = bf2f((hl[q][j >> 1] >> sh) & 0xffffu) + bf2f((pc[q][j >> 1] >> sh) & 0xffffu) * cv[j];
                    yl[j] = hv * bf2f((gg[q][j >> 1] >> sh) & 0xffffu); s1 += yl[j] * yl[j];
                    ya[j] = (l0[q] * bf2f((o0[q][j >> 1] >> sh) & 0xffffu) + l1[q] * bf2f((o1[q][j >> 1] >> sh) & 0xffffu) + l2[q] * bf2f((o2[q][j >> 1] >> sh) & 0xffffu)) * rden; s2 += ya[j] * ya[j]; }
                s1 = wave_sum(s1, lane); s2 = wave_sum(s2, lane);
                const float r1 = frsq(s1 * (1.f / 512.f) + EPS), r2 = frsq(s2 * (1.f / 512.f) + EPS);
                u32x4 m0, m1;
                m0.x = pk2(yl[0] * r1 * gl0[0], yl[1] * r1 * gl0[1]); m0.y = pk2(yl[2] * r1 * gl0[2], yl[3] * r1 * gl0[3]); m0.z = pk2(yl[4] * r1 * gl1[0], yl[5] * r1 * gl1[1]); m0.w = pk2(yl[6] * r1 * gl1[2], yl[7] * r1 * gl1[3]);
                m1.x = pk2(ya[0] * r2 * ga0[0], ya[1] * r2 * ga0[1]); m1.y = pk2(ya[2] * r2 * ga0[2], ya[3] * r2 * ga0[3]); m1.z = pk2(ya[4] * r2 * ga1[0], ya[5] * r2 * ga1[1]); m1.w = pk2(ya[6] * r2 * ga1[2], ya[7] * r2 * ga1[3]);
                *(u32x4*)(v.merged + t * 1024 + lane * 8) = m0; *(u32x4*)(v.merged + t * 1024 + 512 + lane * 8) = m1;
            }
        }
    }
}
}

namespace rtr {
constexpr int WROW = 1040, L_W = 0, L_LG = 96 * WROW, L_CNT = L_LG + 8 * 16 * 48 * 4, L_BASE = L_CNT + 128;
static_assert(L_BASE + 128 <= LDS_MISC, "router LDS map");
__device__ __forceinline__ void phase(const Ctx& c0, bool dry = false) {
    const Ctx c = fresh(c0); LV v = make_lv(c);
    if (dry) { v.counts = (unsigned*)(c.ws + WS_CTL) + 2048; v.list = (int*)v.tmp; v.asg_e = (int*)v.tmp + 32 * T; v.asg_pos = v.asg_e + 2 * T; v.asg_w = (float*)(v.asg_pos + 2 * T); v.rstd2 = v.asg_w + 2 * T; v.rsl = (float*)v.tmp + 40 * T; }
    const int lane = c.lane, r16 = lane & 15, q4 = lane >> 4;
    const float* bg = inp(c, 17) + c.l * 4; const float* be = inp(c, 19) + c.l * 32;
    LAS float* lg = (LAS float*)(c.lds + L_LG) + c.wave * 16 * 48;
    LAS unsigned* cnt = (LAS unsigned*)(c.lds + L_CNT); LAS unsigned* base = (LAS unsigned*)(c.lds + L_BASE);
    const int npass = (T / 16 + c.NGW - 1) / c.NGW;
    for (int ps = 0; ps < npass; ++ps) {
        const int it = ps * c.NGW + c.gw; const bool act = it < T / 16;
        const bf16* xr = v.xb + (size_t)((act ? it : 0) * 16 + r16) * 1024 + 8 * q4;
        f32x4 acc[3] = {{0.f, 0.f, 0.f, 0.f}, {0.f, 0.f, 0.f, 0.f}, {0.f, 0.f, 0.f, 0.f}}; float ss = 0.f;
        for (int half = 0; half < 2; ++half) {
            __syncthreads();
            if (half == 0 && c.tid < 32) cnt[c.tid] = 0u;
#pragma unroll
            for (int j = 0; j < 12; ++j) { const int p = c.tid + 512 * j, rr = p >> 6, o16 = p & 63;
                *(LAS u32x4*)(c.lds + L_W + rr * WROW + o16 * 16) = *(const u32x4*)(v.wr + (size_t)rr * 1024 + half * 512 + o16 * 8); }
            __syncthreads();
#pragma unroll 4
            for (int k0 = 0; k0 < 512; k0 += 32) {
                const u32x4 xw = *(const u32x4*)(xr + half * 512 + k0);
                const bf16x8 ahi = __builtin_bit_cast(bf16x8, xw);
#pragma unroll
                for (int j = 0; j < 4; ++j) { const float a = bf2f(xw[j] & 0xffffu), b = bf2f(xw[j] >> 16); ss += a * a + b * b; }
#pragma unroll
                for (int cb = 0; cb < 3; ++cb) { const LAS unsigned char* wp = c.lds + L_W + (cb * 16 + r16) * WROW + (k0 + 8 * q4) * 2;
                    const bf16x8 bh = *(const LAS bf16x8*)wp, bl = *(const LAS bf16x8*)(wp + 48 * WROW);
                    acc[cb] = __builtin_amdgcn_mfma_f32_16x16x32_bf16(ahi, bh, acc[cb], 0, 0, 0);
                    acc[cb] = __builtin_amdgcn_mfma_f32_16x16x32_bf16(ahi, bl, acc[cb], 0, 0, 0); }
            }
        }
        int ea = 0, eb = 0, la = 0, lb = 0; float w1 = 0.f, w2 = 0.f, rs_keep = 0.f;
        if (act) {
            ss += shx(ss, lane, 16); ss += shx(ss, lane, 32);
            const float rs = frsq(ss * (1.f / 1024.f) + EPS); rs_keep = rs;
#pragma unroll
            for (int reg = 0; reg < 4; ++reg) { const float rsr = __builtin_bit_cast(float, __builtin_amdgcn_ds_bpermute((4 * q4 + reg) << 2, __builtin_bit_cast(int, rs)));
#pragma unroll
                for (int cb = 0; cb < 3; ++cb) lg[(4 * q4 + reg) * 48 + cb * 16 + r16] = acc[cb][reg] * rsr; }
            asm volatile("s_waitcnt lgkmcnt(0)" ::: "memory");
            if (lane < 16) {
                const int t = it * 16 + lane; const LAS float* L = lg + lane * 48;
                v.rstd2[t] = rs;
                float gl4[4];
#pragma unroll
                for (int j = 0; j < 4; ++j) gl4[j] = L[32 + j] + bg[j];
                int g = 0; float gm = gl4[0];
#pragma unroll
                for (int j = 1; j < 4; ++j) if (gl4[j] > gm) { gm = gl4[j]; g = j; }
                float den = 0.f;
#pragma unroll
                for (int j = 0; j < 4; ++j) den += __expf(gl4[j] - gm);
                const float ptop = 1.f / den;
                int i1 = 0; float v1 = L[g * 8] + be[g * 8];
                for (int j = 1; j < 8; ++j) { const float x = L[g * 8 + j] + be[g * 8 + j]; if (x > v1) { v1 = x; i1 = j; } }
                int i2 = -1; float v2 = -INFINITY;
                for (int j = 0; j < 8; ++j) { const float x = L[g * 8 + j] + be[g * 8 + j]; if (j != i1 && x > v2) { v2 = x; i2 = j; } }
                const float e2 = __expf(v2 - v1); w1 = ptop / (1.f + e2); w2 = ptop * e2 / (1.f + e2);
                ea = g * 8 + i1; eb = g * 8 + i2;
                la = (int)atomicAdd((unsigned*)(cnt + ea), 1u); lb = (int)atomicAdd((unsigned*)(cnt + eb), 1u);
            }
        }
        __syncthreads();
        if (c.tid < 32) { const unsigned n = cnt[c.tid]; base[c.tid] = n ? atomicAdd(&v.counts[c.tid], n) : 0u; }
        __syncthreads();
        if (act && lane < 16) {
            const int t = it * 16 + lane; const int pa = (int)base[ea] + la, pb = (int)base[eb] + lb;
            v.asg_e[2 * t] = ea; v.asg_pos[2 * t] = pa; v.asg_w[2 * t] = w1; v.list[(size_t)ea * T + pa] = 2 * t; v.rsl[(size_t)ea * T + pa] = rs_keep;
            v.asg_e[2 * t + 1] = eb; v.asg_pos[2 * t + 1] = pb; v.asg_w[2 * t + 1] = w2; v.list[(size_t)eb * T + pb] = 2 * t + 1; v.rsl[(size_t)eb * T + pb] = rs_keep;
        }
    }
}
}

namespace cmb {
__device__ __forceinline__ void phase(const Ctx& c0, bool dry = false) {
    const Ctx c = fresh(c0); const LV v = make_lv(c);
    LAS int* tstart = moe_plan(c, v.counts); const int lane = c.lane;
    bf16* xbo = dry ? (bf16*)v.tmp : v.xb; float* ro = dry ? v.rstd2 : v.rstd1; const bool last = (c.l == DEPTH - 1) && !dry;
    constexpr int NBT = 4;
    const unsigned char* ys8 = (const unsigned char*)v.ys;
    int ae[NBT][2], ap[NBT][2]; float aw[NBT][2];
#define CMB_ASG(tb) do { _Pragma("unroll") for (int q = 0; q < NBT; ++q) { const int t_ = min((tb) + q * c.NGW, T - 1); \
        ae[q][0] = v.asg_e[2 * t_]; ae[q][1] = v.asg_e[2 * t_ + 1]; ap[q][0] = v.asg_pos[2 * t_]; ap[q][1] = v.asg_pos[2 * t_ + 1]; aw[q][0] = v.asg_w[2 * t_]; aw[q][1] = v.asg_w[2 * t_ + 1]; } } while (0)
    CMB_ASG(c.gw);
    for (int tb = c.gw; tb < T; tb += NBT * c.NGW) {
        size_t r0[NBT], r1[NBT]; float g0[NBT], g1[NBT];
#pragma unroll
        for (int q = 0; q < NBT; ++q) { r0[q] = (size_t)tstart[ae[q][0]] * 256 + ap[q][0]; r1[q] = (size_t)tstart[ae[q][1]] * 256 + ap[q][1]; g0[q] = aw[q][0] * (1.f / pg8::YS_SCALE); g1[q] = aw[q][1] * (1.f / pg8::YS_SCALE); }
        u32x4 xw[NBT][2], y0[NBT], y1[NBT];
#pragma unroll
        for (int q = 0; q < NBT; ++q) { const int t = min(tb + q * c.NGW, T - 1);
            xw[q][0] = *(const u32x4*)(v.xb + (size_t)t * 1024 + lane * 16); xw[q][1] = *(const u32x4*)(v.xb + (size_t)t * 1024 + lane * 16 + 8);
            y0[q] = __builtin_nontemporal_load((const u32x4*)(ys8 + r0[q] * 1024 + lane * 16)); y1[q] = __builtin_nontemporal_load((const u32x4*)(ys8 + r1[q] * 1024 + lane * 16)); }
        if (tb + NBT * c.NGW < T) CMB_ASG(tb + NBT * c.NGW);
#pragma unroll
        for (int q = 0; q < NBT; ++q) { const int t = tb + q * c.NGW; if (t >= T) break;
            float xv[16];
#pragma unroll
            for (int e = 0; e < 4; ++e) {
                const auto a_lo = __builtin_amdgcn_cvt_pk_f32_fp8((int)y0[q][e], false), a_hi = __builtin_amdgcn_cvt_pk_f32_fp8((int)y0[q][e], true);
                const auto b_lo = __builtin_amdgcn_cvt_pk_f32_fp8((int)y1[q][e], false), b_hi = __builtin_amdgcn_cvt_pk_f32_fp8((int)y1[q][e], true);
                const unsigned xa = xw[q][e >> 1][(e & 1) * 2], xb2 = xw[q][e >> 1][(e & 1) * 2 + 1];
                xv[4 * e + 0] = bf2f(xa & 0xffffu) + g0[q] * a_lo[0] + g1[q] * b_lo[0]; xv[4 * e + 1] = bf2f(xa >> 16) + g0[q] * a_lo[1] + g1[q] * b_lo[1];
                xv[4 * e + 2] = bf2f(xb2 & 0xffffu) + g0[q] * a_hi[0] + g1[q] * b_hi[0]; xv[4 * e + 3] = bf2f(xb2 >> 16) + g0[q] * a_hi[1] + g1[q] * b_hi[1]; }
            const size_t i = (size_t)t * 1024 + lane * 16;
            if (last) {
#pragma unroll
                for (int e = 0; e < 4; ++e) *(f32x4*)(v.x + i + 4 * e) = (f32x4){xv[4 * e], xv[4 * e + 1], xv[4 * e + 2], xv[4 * e + 3]}; }
            else { u32x4 w0, w1; w0.x = pk2(xv[0], xv[1]); w0.y = pk2(xv[2], xv[3]); w0.z = pk2(xv[4], xv[5]); w0.w = pk2(xv[6], xv[7]);
                w1.x = pk2(xv[8], xv[9]); w1.y = pk2(xv[10], xv[11]); w1.z = pk2(xv[12], xv[13]); w1.w = pk2(xv[14], xv[15]);
                *(u32x4*)(xbo + i) = w0; *(u32x4*)(xbo + i + 8) = w1; }
            float s2 = 0.f;
#pragma unroll
            for (int e = 0; e < 16; ++e) s2 += xv[e] * xv[e];
            s2 = wave_sum(s2, lane);
            if (lane == 0) ro[t] = frsq(s2 * (1.f / 1024.f) + EPS);
        }
    }
#undef CMB_ASG
}
}

#ifndef REP_C2
#define REP_C2 1
#endif
#ifndef REP_RTR
#define REP_RTR 1
#endif
#ifndef REP_CMB
#define REP_CMB 1
#endif
#ifndef REP_P0
#define REP_P0 1
#endif
#ifndef REP_A
#define REP_A 1
#endif
#ifndef REP_ATT
#define REP_ATT 1
#endif
#ifndef REP_LRU
#define REP_LRU 1
#endif
#ifndef REP_MRG
#define REP_MRG 1
#endif
#ifndef REP_E1
#define REP_E1 1
#endif
#ifndef REP_E2
#define REP_E2 1
#endif
#ifndef OPT_LRU
#define OPT_LRU 1
#endif
#ifndef OPT_MRG
#define OPT_MRG 1
#endif
#ifndef OPT_RTR
#define OPT_RTR 1
#endif
#ifndef OPT_CMB
#define OPT_CMB 1
#endif
#ifndef OPT_B
#define OPT_B 1
#endif
#ifndef OPT_A
#define OPT_A 1
#endif
#ifndef OPT_C2
#define OPT_C2 1
#endif
#ifndef OPT_E1
#define OPT_E1 1
#endif
#ifndef OPT_E2
#define OPT_E2 1
#endif

namespace cg = cooperative_groups;
struct Args { Params p; int coop; int pad; };
__global__ void __launch_bounds__(NTHREADS, 2) mega(Args a) {
    extern __shared__ __attribute__((aligned(16))) unsigned char lds_raw[];
    Ctx c; c.ws = a.p.ws; c.out = a.p.out; c.lds = (LAS unsigned char*)lds_raw;
    c.tid = threadIdx.x; c.lane = c.tid & 63; c.wave = __builtin_amdgcn_readfirstlane(c.tid >> 6);
    c.G = gridDim.x; c.bid = blockIdx.x; c.gw = c.bid * NWAVES + c.wave; c.NGW = c.G * NWAVES; c.gt = c.bid * NTHREADS + c.tid; c.NGT = c.G * NTHREADS; c.l = 0;
    volatile LAS unsigned* misc = (volatile LAS unsigned*)(c.lds + LDS_MISC + 512);
    if (c.tid < 2) misc[c.tid] = 0u;
    if (c.tid == 0) { LAS unsigned long long* tab = (LAS unsigned long long*)(c.lds + LDS_TAB);
#pragma unroll
        for (int i = 0; i < 23; ++i) tab[i] = (unsigned long long)a.p.in[i]; }
    __syncthreads();
    (void)xcd_barrier_post((unsigned*)(c.ws + WS_CTL) + CW_BAR, misc);
#define GRID_BAR() do { const Ctx f_ = fresh(c); XcdBarrier b_; b_.bar = (unsigned*)(f_.ws + WS_CTL) + CW_BAR; b_.x = xb_xcc_id(); b_.st = (volatile LAS unsigned*)(f_.lds + LDS_MISC + 512); xcd_barrier(b_); } while (0)
    for (int rep = 0; rep < REP_P0; ++rep) p0_prologue(c);
    if (a.coop) { cg::this_grid().sync(); }
    else GRID_BAR();
    for (int l = 0; l < DEPTH; ++l) {
        c.l = l;
        if (OPT_A) { for (int rep = 0; rep < REP_A; ++rep) { const Ctx f = fresh(c); const LV v = make_lv(f); pg8::DenseSched S{(const char*)v.xb, (const char*)v.win, T / 256, DIN / 256, D, f.G, f.bid};
            if (CV_AHEAD && f.l == 0 && rep == 0 && !(f.bid & 8)) { convert_items(f, 0, CV_WIN + CV_WOUT, CV_LAYER, f.gw, f.NGW); __syncthreads(); }
            pg8::gemm_phase(f.lds, S, pg8::EpiProj{v.rstd1, v.xl, inp(f, 10) + f.l * 64, inp(f, 11) + f.l * 64});
            if (CV_AHEAD && f.l == 0 && rep == 0 && (f.bid & 8)) { __syncthreads(); convert_items(f, 0, CV_WIN + CV_WOUT, CV_LAYER, f.gw, f.NGW); } } GRID_BAR(); }
        else { { const Ctx f = fresh(c); const LV v = make_lv(f); n_gemm(f, v.xb, v.win, T, DIN, D, EpiProjN{v.rstd1, v.xl, v.gg, v.v, v.tmp}); } GRID_BAR();
            n_qknorm(c); GRID_BAR(); }
        if (0 && OPT_B && OPT_LRU && REP_ATT == 1 && REP_LRU == 1) { if (c.bid & 8) { lru::phase(c); __syncthreads(); attn::phase(c); } else { attn::phase(c); lru::phase(c); } GRID_BAR(); }
        else {
        if (OPT_B) { for (int rep = 0; rep < REP_ATT; ++rep) attn::phase(c); } else n_attn(c);
        if (OPT_LRU) { for (int rep = 0; rep < REP_LRU; ++rep) lru::phase(c); GRID_BAR(); } }
        if (!OPT_LRU) { n_lru_au(c); GRID_BAR(); n_lru_scan(c); GRID_BAR(); }
        if (OPT_MRG) { for (int rep = 0; rep < REP_MRG; ++rep) mrg::phase(c); GRID_BAR(); }
        else { n_lru_carry(c); GRID_BAR(); n_merge(c); GRID_BAR(); }
        if (OPT_C2 && REP_C2 > 1) { const Ctx f = fresh(c); const LV v = make_lv(f); pg8::DenseSched S{(const char*)v.merged, (const char*)v.wout, T / 256, D / 256, D, f.G, f.bid}; pg8::gemm_phase(f.lds, S, pg8::EpiOut{v.xb, (bf16*)v.tmp}); }
        if (OPT_C2) { const Ctx f = fresh(c); const LV v = make_lv(f); pg8::DenseSched S{(const char*)v.merged, (const char*)v.wout, T / 256, D / 256, D, f.G, f.bid}; pg8::gemm_phase(f.lds, S, pg8::EpiOut{v.xb, v.xb}); }
        else { const Ctx f = fresh(c); const LV v = make_lv(f); n_gemm(f, v.merged, v.wout, T, D, D, EpiOutN{v.x, v.xb}); }
        GRID_BAR();
        if (OPT_RTR) { if (REP_RTR > 1) rtr::phase(c, true); rtr::phase(c); } else n_router(c);
        GRID_BAR();
        if (OPT_E1) for (int rep = 0; rep < REP_E1; ++rep) { const Ctx f = fresh(c); const LV v = make_lv(f); LAS int* ts = moe_plan(f, v.counts); pg8::MoeSched<true> S{(const char*)v.xb, (const char*)v.wgu, v.list, v.counts, ts, 1024, f.G, f.bid}; pg8::gemm_phase(f.lds, S, pg8::EpiUp{v.rsl, v.hid}); if (rep == 0) convert_ahead(f, 0, __builtin_amdgcn_readfirstlane(ts[NE]) * 4); }
        else n_moe_up(c);
        GRID_BAR();
        if (OPT_E2) for (int rep = 0; rep < REP_E2; ++rep) { const Ctx f = fresh(c); const LV v = make_lv(f); LAS int* ts = moe_plan(f, v.counts); pg8::MoeSched<false> S{(const char*)v.hid, (const char*)v.wd, v.list, v.counts, ts, 512, f.G, f.bid}; pg8::gemm_phase(f.lds, S, pg8::EpiDown{(unsigned char*)v.ys}); if (rep == 0) convert_ahead(f, 1, __builtin_amdgcn_readfirstlane(ts[NE]) * 4); }
        else n_moe_down(c);
        GRID_BAR();
        if (OPT_CMB) { if (REP_CMB > 1) cmb::phase(c, true); cmb::phase(c); } else n_combine(c);
        GRID_BAR();
    }
}

extern "C" void kernel_launch(void* const* d_in, const int* in_sizes, int n_in, void* d_out, int out_size, void* d_ws, size_t ws_size, hipStream_t stream) {
    static int grid = 0;
    if (grid == 0) {
        if (n_in != 23 || ws_size < WS_END) { fprintf(stderr, "kernel_launch: unexpected n_in %d or ws_size %zu (< %zu)\n", n_in, ws_size, (size_t)WS_END); grid = -1; return; }
        int dev = 0, cus = 0, per_cu = 0;
        (void)hipGetDevice(&dev); (void)hipDeviceGetAttribute(&cus, hipDeviceAttributeMultiprocessorCount, dev);
        (void)hipFuncSetAttribute((const void*)mega, hipFuncAttributeMaxDynamicSharedMemorySize, LDS_BYTES);
        (void)hipOccupancyMaxActiveBlocksPerMultiprocessor(&per_cu, (const void*)mega, NTHREADS, LDS_BYTES);
        if (per_cu < 1) { fprintf(stderr, "kernel_launch: occupancy query says %d blocks per CU\n", per_cu); per_cu = 1; }
        grid = cus * 1;
        fprintf(stderr, "kernel_launch: cus %d, per_cu %d, grid %d\n", cus, per_cu, grid);
    }
    if (grid < 0) return;
    (void)hipMemsetAsync((unsigned char*)d_ws + WS_CTL, 0, CTL_BYTES, stream);
    Args a{};
    for (int i = 0; i < 23; ++i) a.p.in[i] = (const float*)d_in[i];
    a.p.out = (float*)d_out; a.p.ws = (unsigned char*)d_ws; a.coop = 1; a.pad = 0;
    void* args[] = {&a};
    hipError_t e = hipLaunchCooperativeKernel((const void*)mega, dim3(grid), dim3(NTHREADS), args, LDS_BYTES, stream);
    if (e != hipSuccess) fprintf(stderr, "cooperative launch failed: %s (grid %d)\n", hipGetErrorString(e), grid);
}
```

```cpp
#include <hip/hip_runtime.h>
#include <hip/hip_cooperative_groups.h>
#include <cstdio>
#include <cstdint>
#include <cmath>

constexpr int NB = 8, SEQ = 4096, T = NB * SEQ, D = 1024, DEPTH = 4;
constexpr int DL = 512, DA = 512, NHEAD = 8, HD = 64, DIN = 2560;
constexpr int NE = 32, DE = 512, NGRP = 4, EPG = 8;
constexpr int NCHUNK = SEQ / 32;
constexpr int SLAB_ROWS = 2 * T + NE * 256;
constexpr float EPS = 1e-6f;
constexpr float QSCALE = 0.125f * 1.4426950408889634f;

typedef unsigned short bf16;
typedef short bf16x8 __attribute__((ext_vector_type(8)));
typedef float f32x4 __attribute__((ext_vector_type(4)));
typedef unsigned u32x4 __attribute__((ext_vector_type(4)));
typedef unsigned u32x2 __attribute__((ext_vector_type(2)));
#define LAS __attribute__((address_space(3)))

constexpr size_t MiB = 1u << 20;
constexpr size_t WS_CTL = 0, CTL_BYTES = 1 * MiB;
constexpr size_t WS_WIN = 1 * MiB;
constexpr size_t WS_WOUT = WS_WIN + 20 * MiB;
constexpr size_t WS_WGU = WS_WOUT + 8 * MiB;
constexpr size_t WS_WD = WS_WGU + 256 * MiB;
constexpr size_t WS_WR = WS_WD + 128 * MiB;
constexpr size_t WS_LRUW = WS_WR + 1 * MiB;
constexpr size_t WS_SP = WS_LRUW + 1 * MiB;
constexpr size_t WS_XB = WS_SP + 1 * MiB;
constexpr size_t WS_RSTD1 = WS_XB + 64 * MiB;
constexpr size_t WS_RSTD2 = WS_RSTD1 + 128 * 1024;
constexpr size_t WS_ASG = WS_RSTD2 + 128 * 1024;
constexpr size_t WS_LIST = WS_ASG + 1 * MiB;
constexpr size_t WS_ACT = WS_LIST + 4 * MiB;
constexpr size_t A_XL = 0, A_GG = 32 * MiB, A_Q = 64 * MiB, A_K = 96 * MiB, A_V = 128 * MiB;
constexpr size_t A_OBR = 160 * MiB;
constexpr size_t A_LBR = 256 * MiB;
constexpr size_t A_HL = 260 * MiB, A_PC = 292 * MiB;
constexpr size_t A_AGG = 324 * MiB;
static_assert(A_GG - A_XL == (size_t)T * 512 * 2 && A_Q - A_GG == A_GG - A_XL && A_K - A_Q == A_GG - A_XL && A_V - A_K == A_GG - A_XL, "EpiProj section stride");
constexpr size_t A_MERGED = A_Q;
constexpr size_t A_HID = 0;
constexpr size_t A_YS = 72 * MiB;
constexpr size_t ACT_BYTES = 332 * MiB;
constexpr size_t WS_TMP = WS_ACT + ACT_BYTES;
constexpr size_t WS_END = WS_TMP + 128 * MiB;
static_assert(WS_END <= 1024 * MiB, "workspace map must fit 1 GiB");
constexpr int CW_CNT = 64;

struct Params {
    const float* in[23];
    float* out;
    unsigned char* ws;
};
constexpr int NWAVES = 8, NTHREADS = 512;
constexpr int LDS_BYTES = 147456;
constexpr int LDS_MISC = 143360;
constexpr int LDS_TAB = LDS_MISC + 3072;
constexpr int CW_BAR = 4096;
struct Ctx { unsigned char* ws; float* out; LAS unsigned char* lds; int tid, lane, wave, G, bid, gw, NGW, gt, NGT, l; };
#define GAS __attribute__((address_space(1)))
__device__ __forceinline__ unsigned char* as_global(unsigned long long a) { return (unsigned char*)(GAS unsigned char*)a; }
__device__ __forceinline__ const float* inp(const Ctx& c, int i) {
    const LAS unsigned* tab = (const LAS unsigned*)(c.lds + LDS_TAB) + 2 * i;
    const unsigned lo = __builtin_amdgcn_readfirstlane(tab[0]), hi = __builtin_amdgcn_readfirstlane(tab[1]);
    return (const float*)as_global(((unsigned long long)hi << 32) | lo);
}
__device__ __forceinline__ Ctx fresh(const Ctx& c0) {
    Ctx c; unsigned long long w = (unsigned long long)c0.ws, o = (unsigned long long)c0.out; unsigned l3 = (unsigned)(uintptr_t)c0.lds; int t = c0.tid, G = c0.G, b = c0.bid, l = c0.l;
    asm volatile("" : "+s"(w), "+s"(o), "+s"(l3), "+v"(t), "+s"(G), "+s"(b), "+s"(l));
    c.ws = as_global(w); c.out = (float*)as_global(o); c.lds = (LAS unsigned char*)(uintptr_t)l3; c.tid = t; c.lane = t & 63; c.wave = __builtin_amdgcn_readfirstlane(t >> 6); c.G = G; c.bid = b; c.l = l;
    c.gw = b * NWAVES + c.wave; c.NGW = G * NWAVES; c.gt = b * NTHREADS + t; c.NGT = G * NTHREADS; return c;
}
__device__ __forceinline__ unsigned char* wsl(const Ctx& c) { unsigned long long w = (unsigned long long)c.ws; asm volatile("" : "+s"(w)); return as_global(w); }

typedef float f32x2n __attribute__((ext_vector_type(2)));
typedef __bf16 bf16x2n __attribute__((ext_vector_type(2)));
__device__ __forceinline__ unsigned pk2(float lo, float hi) { const f32x2n f = {lo, hi}; const bf16x2n b = __builtin_convertvector(f, bf16x2n); return __builtin_bit_cast(unsigned, b); }
__device__ __forceinline__ unsigned f2bf(float f) { return pk2(f, 0.f) & 0xffffu; }
__device__ __forceinline__ float bf2f(unsigned h) { return __builtin_bit_cast(float, h << 16); }
__device__ __forceinline__ float shx(float v, int lane, int o) { return __builtin_bit_cast(float, __builtin_amdgcn_ds_bpermute((lane ^ o) << 2, __builtin_bit_cast(int, v))); }
__device__ __forceinline__ float wave_sum(float v, int lane) {
#pragma unroll
    for (int o = 1; o < 64; o <<= 1) v += shx(v, lane, o);
    return v;
}
__device__ __forceinline__ float frcp(float x) { return __builtin_amdgcn_rcpf(x); }
__device__ __forceinline__ float fsqrt(float x) { return __builtin_amdgcn_sqrtf(x); }
__device__ __forceinline__ float frsq(float x) { return __builtin_amdgcn_rsqf(x); }
__device__ __forceinline__ float fexp(float x) { return __builtin_amdgcn_exp2f(x * 1.4426950408889634f); }
__device__ __forceinline__ float gelu_tanh(float x) {
    const float z = 0.7978845608028654f * (x + 0.044715f * x * x * x);
    const float e = fexp(2.f * z);
    return (e > 3.0e38f) ? x : x * e * frcp(1.f + e);
}
__device__ __forceinline__ float sigmoidf_(float x) { return frcp(1.f + fexp(-x)); }

__host__ __device__ __forceinline__ int win_row(int n) {
    if (n < 1024 || n >= 2048) return n;
    const int s = (n - 1024) / 512, c = (n - 1024) % 512, head = c / 64, dim = c % 64;
    const int pn = 4 + 2 * s + head / 4, wc = head % 4, bj = dim / 32, w = dim % 32;
    return 256 * pn + 128 * bj + 32 * wc + w;
}
__host__ __device__ __forceinline__ void win_row_inv(int row, int& s, int& head, int& dim) {
    const int pn = row / 256, tl = row % 256, bj = tl / 128, wc = (tl % 128) / 32, w = tl % 32;
    s = (pn - 4) / 2; head = ((pn - 4) & 1) * 4 + wc; dim = 32 * bj + w;
}
__host__ __device__ __forceinline__ int gu_row(int j, int up) { return (j / 128) * 256 + up * 128 + (j % 128); }

typedef short s16x4_t __attribute__((ext_vector_type(4)));
__device__ __forceinline__ unsigned cvtpk_bf16(float lo, float hi) { return pk2(lo, hi); }
template <class RowMap>
__device__ __forceinline__ void transpose_item(const float* W, int N, int k0, int n0, const float* gain, bf16* WT, int Kdst, RowMap rm, LAS unsigned char* tile, int lane) {
    const int kr = lane >> 4, c4 = lane & 15;
    f32x4 v[16]; float g[16];
#pragma unroll
    for (int i = 0; i < 16; ++i) { v[i] = __builtin_nontemporal_load((const f32x4*)(W + (size_t)(k0 + 4 * i + kr) * N + n0 + 4 * c4)); g[i] = gain ? gain[k0 + 4 * i + kr] : 1.f; }
#pragma unroll
    for (int i = 0; i < 16; ++i) { const f32x4 t = v[i] * g[i]; u32x2 w; w.x = cvtpk_bf16(t[0], t[1]); w.y = cvtpk_bf16(t[2], t[3]); *(LAS u32x2*)(tile + (4 * i + kr) * 192 + c4 * 8) = w; }
    asm volatile("s_waitcnt lgkmcnt(0)" ::: "memory");
    const LAS unsigned char* rp = tile + ((lane & 15) >> 2) * 192 + (lane >> 4) * 32 + (lane & 3) * 8;
    bf16x8 o[8];
#pragma unroll
    for (int c = 0; c < 8; ++c) {
        const s16x4_t a = __builtin_bit_cast(s16x4_t, __builtin_amdgcn_ds_read_tr16_b64_v4i16((LAS s16x4_t*)(rp + (8 * c) * 192)));
        const s16x4_t b = __builtin_bit_cast(s16x4_t, __builtin_amdgcn_ds_read_tr16_b64_v4i16((LAS s16x4_t*)(rp + (8 * c + 4) * 192)));
        o[c] = (bf16x8){a[0], a[1], a[2], a[3], b[0], b[1], b[2], b[3]};
    }
    asm volatile("s_waitcnt lgkmcnt(0)" ::: "memory");
#pragma unroll
    for (int c = 0; c < 8; ++c) *(LAS bf16x8*)(tile + lane * 144 + c * 16) = o[c];
    asm volatile("s_waitcnt lgkmcnt(0)" ::: "memory");
#pragma unroll
    for (int j = 0; j < 8; ++j) { const int n = 8 * j + (lane >> 3);
        const bf16x8 r = *(const LAS bf16x8*)(tile + n * 144 + (lane & 7) * 16);
        *(bf16x8*)(WT + (size_t)rm(n0 + n) * Kdst + k0 + 8 * (lane & 7)) = r; }
    asm volatile("s_waitcnt lgkmcnt(0)" ::: "memory");
}
__host__ __device__ __forceinline__ int adj_row(int n) { const int c = n & 255; return (n & ~255) + ((c >> 5) & 1) * 128 + (c >> 6) * 32 + (c & 31); }
struct RmId { __device__ int operator()(int n) const { return adj_row(n); } };
struct RmWin { __device__ int operator()(int n) const { return adj_row(n); } };
struct RmDown { __device__ int operator()(int n) const { const int c = n & 255, wc = c >> 6, rest = c & 63; return (n & ~255) + ((rest >> 3) & 1) * 128 + wc * 32 + (rest >> 4) * 8 + (rest & 7); } };
struct RmGu { int up; __device__ int operator()(int n) const { return gu_row(n, up); } };

constexpr int CV_WIN = 16 * 40, CV_WOUT = 16 * 16, CV_G = 16 * 8, CV_D = 8 * 16, CV_LAYER = CV_WIN + CV_WOUT + NE * (2 * CV_G + CV_D);
__device__ __forceinline__ void convert_items(const Ctx& c, int l, int lo, int hi, int widx, int nworkers) {
    LAS unsigned char* scr = c.lds + c.wave * 16384; unsigned char* ws = wsl(c); const int lane = c.lane;
    for (int it = lo + widx; it < hi; it += nworkers) {
        int r = it;
        if (r < CV_WIN) { const int kb = r / 40, nb = r % 40;
            transpose_item(inp(c, 2) + (size_t)l * D * DIN, DIN, 64 * kb, 64 * nb, inp(c, 1) + l * D, (bf16*)(ws + WS_WIN) + (size_t)l * DIN * D, D, RmWin{}, scr, lane); continue; }
        r -= CV_WIN;
        if (r < CV_WOUT) { const int kb = r / 16, nb = r % 16;
            transpose_item(inp(c, 14) + (size_t)l * D * D, D, 64 * kb, 64 * nb, nullptr, (bf16*)(ws + WS_WOUT) + (size_t)l * D * D, D, RmId{}, scr, lane); continue; }
        r -= CV_WOUT;
        const int e = r / (2 * CV_G + CV_D); r %= (2 * CV_G + CV_D);
        bf16* gu = (bf16*)(ws + WS_WGU) + ((size_t)l * NE + e) * 1024 * 1024;
        if (r < CV_G) { const int kb = r / 8, nb = r % 8;
            transpose_item(inp(c, 20) + ((size_t)l * NE + e) * D * DE, DE, 64 * kb, 64 * nb, inp(c, 15) + l * D, gu, D, RmGu{0}, scr, lane); continue; }
        r -= CV_G;
        if (r < CV_G) { const int kb = r / 8, nb = r % 8;
            transpose_item(inp(c, 21) + ((size_t)l * NE + e) * D * DE, DE, 64 * kb, 64 * nb, inp(c, 15) + l * D, gu, D, RmGu{1}, scr, lane); continue; }
        r -= CV_G;
        { const int kb = r / 16, nb = r % 16;
            transpose_item(inp(c, 22) + ((size_t)l * NE + e) * DE * D, D, 64 * kb, 64 * nb, nullptr, (bf16*)(ws + WS_WD) + ((size_t)l * NE + e) * D * DE, DE, RmDown{}, scr, lane); }
    }
}
#ifndef CV_AHEAD
#define CV_AHEAD 1
#endif
#ifndef CV_Q1
#define CV_Q1 56
#endif
#ifndef CV_Q2
#define CV_Q2 32
#endif
__device__ __forceinline__ void convert_ahead(const Ctx& c0, int which, int nunits) {
    const Ctx c = fresh(c0);
    if (!CV_AHEAD || c.l + 1 >= DEPTH) return;
    __syncthreads();
    const int rem = nunits % c.G, nspare = rem ? c.G - rem : 0;
    const int q1 = min(CV_LAYER, CV_Q1 * nspare), q2 = min(CV_LAYER, q1 + CV_Q2 * nspare);
    if (nspare && c.bid >= rem) { const int rank = c.bid - rem; convert_items(c, c.l + 1, which ? q1 : 0, which ? q2 : q1, rank * NWAVES + c.wave, nspare * NWAVES); }
    if (which) convert_items(c, c.l + 1, q2, CV_LAYER, c.gw, c.NGW);
}
__device__ __forceinline__ void p0_prologue(const Ctx& c0) {
    const Ctx c = fresh(c0);
    const int gw = c.gw, NGW = c.NGW, lane = c.lane;
    unsigned char* ws = wsl(c);
    if (!CV_AHEAD) for (int l = 0; l < DEPTH; ++l) convert_items(c, l, 0, CV_LAYER, gw, NGW);
    const int gt = gw * 64 + lane, NGT = NGW * 64;
    for (int m0 = gw; m0 < T; m0 += 2 * NGW) {
        const int m1 = m0 + NGW < T ? m0 + NGW : m0;
        const f32x4* xr0 = (const f32x4*)(inp(c, 0) + (size_t)m0 * D) + lane; const f32x4* xr1 = (const f32x4*)(inp(c, 0) + (size_t)m1 * D) + lane;
        f32x4 va[4], vb[4];
#pragma unroll
        for (int j = 0; j < 4; ++j) { va[j] = __builtin_nontemporal_load(xr0 + 64 * j); vb[j] = __builtin_nontemporal_load(xr1 + 64 * j); }
        if (m0 == gw) {
        if (CV_AHEAD) convert_items(c, 0, 0, CV_WIN + CV_WOUT, gw, NGW);
    for (int i = gt; i < DEPTH * 48 * 1024; i += NGT) {
        const int l = i / (48 * 1024), col = (i / 1024) % 48, k = i % 1024;
        float w = 0.f;
        if (col < 32) w = inp(c, 18)[((size_t)l * D + k) * 32 + col]; else if (col < 36) w = inp(c, 16)[((size_t)l * D + k) * 4 + (col - 32)];
        w *= inp(c, 15)[l * D + k];
        const unsigned hi = f2bf(w); const float res = w - bf2f(hi);
        bf16* wr = (bf16*)(ws + WS_WR) + (size_t)l * 2 * 48 * 1024;
        wr[col * 1024 + k] = (bf16)hi; wr[48 * 1024 + col * 1024 + k] = (bf16)f2bf(res);
    }
    for (int which = 0; which < 2; ++which) {
        const float* srcw = inp(c, which ? 7 : 5);
        for (int j = gt; j < DEPTH * 8 * 4096; j += NGT) {
            const int l = j / (8 * 4096), h = (j / 4096) % 8, n = (j / 64) % 64, k = j % 64;
            ((bf16*)(ws + WS_LRUW))[(((size_t)l * 2 + which) * 8 + h) * 4096 + n * 64 + k] = (bf16)f2bf(srcw[((size_t)l * 8 + h) * 4096 + k * 64 + n]);
        }
    }
    for (int i = gt; i < DEPTH * 512; i += NGT) { const float lam = inp(c, 9)[i]; ((float*)(ws + WS_SP))[i] = log1pf(__expf(-lam)); }
        }
        u32x2* xb0 = (u32x2*)((bf16*)(ws + WS_XB) + (size_t)m0 * D) + lane; u32x2* xb1 = (u32x2*)((bf16*)(ws + WS_XB) + (size_t)m1 * D) + lane;
        float s0 = 0.f, s1 = 0.f;
#pragma unroll
        for (int j = 0; j < 4; ++j) { const f32x4 v = va[j]; s0 += (v.x * v.x + v.y * v.y) + (v.z * v.z + v.w * v.w); u32x2 w; w.x = pk2(v.x, v.y); w.y = pk2(v.z, v.w); xb0[64 * j] = w; }
        if (m1 != m0) {
#pragma unroll
            for (int j = 0; j < 4; ++j) { const f32x4 v = vb[j]; s1 += (v.x * v.x + v.y * v.y) + (v.z * v.z + v.w * v.w); u32x2 w; w.x = pk2(v.x, v.y); w.y = pk2(v.z, v.w); xb1[64 * j] = w; } }
        s0 = wave_sum(s0, lane); s1 = wave_sum(s1, lane);
        if (lane == 0) { ((float*)(ws + WS_RSTD1))[m0] = 1.f / sqrtf(s0 * (1.f / D) + EPS); if (m1 != m0) ((float*)(ws + WS_RSTD1))[m1] = 1.f / sqrtf(s1 * (1.f / D) + EPS); }
    }
}

#define XB_TMO      128
#define XB_XCNT(j)  (256  + 64 * (j))
#define XB_XSUB(j)  (1280 + 64 * (j))
#define XB_XGEN(j)  (2304 + 64 * (j))
#define XB_TOP      3328
#define XB_TOPGEN   3392
#define XCD_BAR_WORDS 3456
#define XB_SPIN_CAP (1u << 18)
__device__ __forceinline__ unsigned xb_ld(unsigned* p)              { return __hip_atomic_load(p, __ATOMIC_RELAXED, __HIP_MEMORY_SCOPE_AGENT); }
__device__ __forceinline__ unsigned xb_add(unsigned* p, unsigned v) { return __hip_atomic_fetch_add(p, v, __ATOMIC_RELAXED, __HIP_MEMORY_SCOPE_AGENT); }
__device__ __forceinline__ unsigned xb_xcc_id() { return (unsigned)__builtin_amdgcn_s_getreg((3 << 11) | 20) & 0xFu; }
#define XB_SPIN(cond, bar) do { unsigned _sp = 0; while (cond) { __builtin_amdgcn_s_sleep(1); \
    if ((++_sp & 255u) == 0u) { if (xb_ld(&(bar)[XB_TMO])) break; if (_sp > XB_SPIN_CAP) { atomicAdd(&(bar)[XB_TMO], 1u); break; } } } } while (0)
struct XcdBarrier { unsigned* bar; unsigned x; volatile LAS unsigned* st; };
__device__ __forceinline__ XcdBarrier xcd_barrier_post(unsigned* bar, volatile LAS unsigned* st) {
    XcdBarrier b; b.bar = bar; b.x = xb_xcc_id(); b.st = st;
    if (threadIdx.x == 0) (void)xb_add(&bar[XB_XCNT(b.x)], 1u);
    return b;
}
__device__ __forceinline__ void xcd_barrier_complete(unsigned* bar, unsigned x, unsigned& nloc, unsigned& nx) {
    const unsigned G = gridDim.x * gridDim.y * gridDim.z;
    unsigned sum, cnt, mine, sp = 0u;
    for (;;) {
        sum = 0u; cnt = 0u; mine = 0u;
#pragma unroll
        for (unsigned j = 0; j < 16; ++j) { const unsigned c = xb_ld(&bar[XB_XCNT(j)]); sum += c; cnt += (c > 0u) ? 1u : 0u; mine = (j == x) ? c : mine; }
        if (sum == G) break;
        __builtin_amdgcn_s_sleep(1);
        if ((++sp & 255u) == 0u) { if (xb_ld(&bar[XB_TMO])) break; if (sp > XB_SPIN_CAP) { atomicAdd(&bar[XB_TMO], 1u); break; } }
    }
    nloc = mine > 0u ? mine : 1u; nx = cnt > 0u ? cnt : 1u;
}
__device__ __forceinline__ void xcd_barrier(const XcdBarrier& b) {
    asm volatile("s_waitcnt vmcnt(0)" ::: "memory");
    __syncthreads();
    if (threadIdx.x == 0) {
        unsigned* bar = b.bar;
        __builtin_amdgcn_s_waitcnt(0);
        unsigned nloc = b.st[0], nx = b.st[1];
        if (nloc == 0u) { xcd_barrier_complete(bar, b.x, nloc, nx); b.st[0] = nloc; b.st[1] = nx; }
        const unsigned old = xb_add(&bar[XB_XSUB(b.x)], 1u);
        const unsigned gen = old / nloc;
        if (old + 1u == (gen + 1u) * nloc) {
            __builtin_amdgcn_fence(__ATOMIC_RELEASE, "agent");
            asm volatile("s_waitcnt vmcnt(0)" ::: "memory");
            const unsigned og = xb_add(&bar[XB_TOP], 1u);
            const unsigned tg = og / nx;
            if (og + 1u == (tg + 1u) * nx) xb_add(&bar[XB_TOPGEN], 1u);
            else XB_SPIN(xb_ld(&bar[XB_TOPGEN]) == tg, bar);
            __builtin_amdgcn_fence(__ATOMIC_ACQUIRE, "agent");
            xb_add(&bar[XB_XGEN(b.x)], 1u);
            asm volatile("s_waitcnt vmcnt(0)" ::: "memory");
        } else {
            XB_SPIN(xb_ld(&bar[XB_XGEN(b.x)]) == gen, bar);
            __builtin_amdgcn_fence(__ATOMIC_ACQUIRE, "agent");
            asm volatile("s_waitcnt vmcnt(0)" ::: "memory");
        }
    }
    __syncthreads();
}

struct LV {
    const bf16 *win, *wout, *wgu, *wd, *wr, *wat, *wxt; const float* sp; unsigned* counts;
    bf16 *xb, *xl, *gg, *q, *k, *v, *obr, *hl, *pc, *merged, *hid, *ys;
    float *lbr, *aggA, *aggH, *carry, *rstd1, *rstd2, *tmp, *asg_w, *x, *rsl; int *asg_e, *asg_pos, *list;
};
__device__ __forceinline__ LV make_lv(const Ctx& c) {
    LV v; const int l = c.l; unsigned char* ws = wsl(c); unsigned char* act = ws + WS_ACT;
    v.win = (const bf16*)(ws + WS_WIN) + (size_t)l * DIN * D; v.wout = (const bf16*)(ws + WS_WOUT) + (size_t)l * D * D;
    v.wgu = (const bf16*)(ws + WS_WGU) + (size_t)l * NE * 1024 * 1024; v.wd = (const bf16*)(ws + WS_WD) + (size_t)l * NE * 1024 * 512;
    v.wr = (const bf16*)(ws + WS_WR) + (size_t)l * 2 * 48 * 1024; v.wat = (const bf16*)(ws + WS_LRUW) + (size_t)l * 2 * 8 * 4096; v.wxt = v.wat + 8 * 4096;
    v.sp = (const float*)(ws + WS_SP) + l * 512; v.counts = (unsigned*)(ws + WS_CTL) + CW_CNT + 64 * l;
    v.xb = (bf16*)(ws + WS_XB); v.xl = (bf16*)(act + A_XL); v.gg = (bf16*)(act + A_GG); v.q = (bf16*)(act + A_Q); v.k = (bf16*)(act + A_K); v.v = (bf16*)(act + A_V);
    v.obr = (bf16*)(act + A_OBR); v.hl = (bf16*)(act + A_HL); v.pc = (bf16*)(act + A_PC); v.merged = (bf16*)(act + A_MERGED); v.hid = (bf16*)(act + A_HID); v.ys = (bf16*)(act + A_YS);
    v.lbr = (float*)(act + A_LBR); v.aggA = (float*)(act + A_AGG); v.aggH = v.aggA + NB * NCHUNK * 512; v.carry = v.aggH + NB * NCHUNK * 512;
    v.rstd1 = (float*)(ws + WS_RSTD1); v.rstd2 = (float*)(ws + WS_RSTD2); v.tmp = (float*)(ws + WS_TMP);
    v.asg_e = (int*)(ws + WS_ASG); v.asg_pos = v.asg_e + 2 * T; v.asg_w = (float*)(v.asg_pos + 2 * T); v.list = (int*)(ws + WS_LIST); v.x = c.out; v.rsl = (float*)(ws + WS_TMP + 64 * MiB);
    return v;
}

template <class Epi>
__device__ __forceinline__ void n_gemm(const Ctx& c0, const bf16* A, const bf16* Bt, int M, int N, int K, const Epi& epi) {
    const Ctx c = fresh(c0);
    const int lane = c.lane, r16 = lane & 15, q4 = lane >> 4, tn_n = N / 64, ntile = (M / 64) * tn_n;
    for (int wv = c.gw; wv < ntile; wv += c.NGW) {
        const int tm = wv / tn_n, tn = wv % tn_n;
        f32x4 acc[4][4];
#pragma unroll
        for (int i = 0; i < 4; ++i)
#pragma unroll
            for (int j = 0; j < 4; ++j) acc[i][j] = (f32x4){0.f, 0.f, 0.f, 0.f};
        for (int k0 = 0; k0 < K; k0 += 32) {
            bf16x8 a[4], b[4];
#pragma unroll
            for (int i = 0; i < 4; ++i) { a[i] = *(const bf16x8*)(A + (size_t)(tm * 64 + i * 16 + r16) * K + k0 + 8 * q4); b[i] = *(const bf16x8*)(Bt + (size_t)(tn * 64 + i * 16 + r16) * K + k0 + 8 * q4); }
#pragma unroll
            for (int i = 0; i < 4; ++i)
#pragma unroll
                for (int j = 0; j < 4; ++j) acc[i][j] = __builtin_amdgcn_mfma_f32_16x16x32_bf16(a[i], b[j], acc[i][j], 0, 0, 0);
        }
#pragma unroll
        for (int i = 0; i < 4; ++i)
#pragma unroll
            for (int j = 0; j < 4; ++j)
#pragma unroll
                for (int r = 0; r < 4; ++r) epi(tm * 64 + i * 16 + 4 * q4 + r, tn * 64 + j * 16 + r16, acc[i][j][r]);
    }
}
struct EpiProjN {
    const float* rstd; bf16 *xl, *gg, *v; float* qk;
    __device__ void operator()(int row, int n, float a) const {
        const float val = a * rstd[row];
        if (n < 512) xl[(size_t)row * 512 + n] = (bf16)f2bf(val);
        else if (n < 1024) gg[(size_t)row * 512 + n - 512] = (bf16)f2bf(gelu_tanh(val));
        else if (n < 2048) { int s, head, dim; win_row_inv(n, s, head, dim); qk[(size_t)row * 1024 + s * 512 + head * 64 + dim] = val; }
        else v[(size_t)row * 512 + n - 2048] = (bf16)f2bf(val);
    }
};
struct EpiOutN { float* x; bf16* xb; __device__ void operator()(int row, int n, float a) const { const size_t i = (size_t)row * 1024 + n; xb[i] = (bf16)f2bf(bf2f(xb[i]) + a); } };

__device__ __forceinline__ void n_qknorm(const Ctx& c0) {
    const Ctx c = fresh(c0); const LV v = make_lv(c);
    const float* qg = inp(c, 10) + c.l * 64; const float* kg = inp(c, 11) + c.l * 64;
    for (int i = c.gt; i < T * 16; i += c.NGT) {
        const int row = i / 16, s = (i / 8) % 2, head = i % 8;
        const float* src = v.tmp + (size_t)row * 1024 + s * 512 + head * 64;
        float ss = 0.f; for (int d = 0; d < 64; ++d) ss += src[d] * src[d];
        const float r = 1.f / sqrtf(ss * (1.f / 64.f) + EPS);
        bf16* dst = (s ? v.k : v.q) + (size_t)row * 512 + head * 64;
        for (int d = 0; d < 64; ++d) dst[d] = (bf16)f2bf(src[d] * r * (s ? kg[d] : qg[d] * QSCALE));
    }
}
__device__ __forceinline__ void n_attn(const Ctx& c0) {
    const Ctx c = fresh(c0); const LV v = make_lv(c);
    for (int i = c.gt; i < T * 8; i += c.NGT) {
        const int t = i / 8, h = i % 8, b = t / SEQ, pos = t % SEQ;
        float qf[64];
        { const bf16* qp = v.q + (size_t)t * 512 + h * 64;
#pragma unroll
          for (int d = 0; d < 64; ++d) qf[d] = bf2f(qp[d]); }
        for (int br = 0; br < 3; ++br) {
            const int dil = br == 0 ? 1 : (br == 1 ? 4 : 16);
            float o[64];
#pragma unroll
            for (int d = 0; d < 64; ++d) o[d] = 0.f;
            float l = 0.f;
            for (int m = 0; m <= 128; ++m) {
                const int kp = pos - m * dil; if (kp < 0) break;
                const size_t off = ((size_t)b * SEQ + kp) * 512 + h * 64;
                float s = 0.f;
#pragma unroll
                for (int d8 = 0; d8 < 8; ++d8) { const bf16x8 kv = *(const bf16x8*)(v.k + off + d8 * 8);
#pragma unroll
                    for (int j = 0; j < 8; ++j) s += qf[d8 * 8 + j] * bf2f((unsigned short)kv[j]); }
                const float pw = exp2f(s); l += pw;
#pragma unroll
                for (int d8 = 0; d8 < 8; ++d8) { const bf16x8 vv = *(const bf16x8*)(v.v + off + d8 * 8);
#pragma unroll
                    for (int j = 0; j < 8; ++j) o[d8 * 8 + j] += pw * bf2f((unsigned short)vv[j]); }
            }
            const float rl = 1.f / l;
            bf16* op = v.obr + (size_t)br * T * 512 + (size_t)t * 512 + h * 64;
#pragma unroll
            for (int d = 0; d < 64; ++d) op[d] = (bf16)f2bf(o[d] * rl);
            v.lbr[(size_t)br * T * 8 + (size_t)t * 8 + h] = l;
        }
    }
}
__device__ __forceinline__ void n_lru_au(const Ctx& c0) {
    const Ctx c = fresh(c0); const LV v = make_lv(c);
    const int l = c.l; const float* cw = inp(c, 3) + l * 4 * 512; const float* cb = inp(c, 4) + l * 512; const float* ba = inp(c, 6) + l * 512; const float* bx = inp(c, 8) + l * 512;
    float* a_out = v.tmp; float* u_out = v.tmp + (size_t)T * 512;
    for (int i = c.gt; i < T * 512; i += c.NGT) {
        const int t = i / 512, ch0 = i % 512, pos = t % SEQ, h = ch0 / 64, n = ch0 % 64;
        float ra = 0.f, rx = 0.f, xc_own = 0.f;
        for (int kk = 0; kk < 64; ++kk) {
            const int ch = h * 64 + kk; float xc = cb[ch];
            for (int j = 0; j < 4; ++j) { const int pp = pos - 3 + j; if (pp >= 0) xc += cw[j * 512 + ch] * bf2f(v.xl[(size_t)(t - 3 + j) * 512 + ch]); }
            if (kk == n) xc_own = xc;
            const float xcb = bf2f(f2bf(xc));
            ra += xcb * bf2f(v.wat[(h * 64 + n) * 64 + kk]); rx += xcb * bf2f(v.wxt[(h * 64 + n) * 64 + kk]);
        }
        const float r = sigmoidf_(ra + ba[ch0]), ig = sigmoidf_(rx + bx[ch0]);
        const float log_a = -8.f * r * v.sp[ch0];
        const float a = __expf(log_a);
        a_out[i] = a; u_out[i] = sqrtf(fmaxf(1.f - a * a, 0.f)) * (ig * xc_own);
    }
}
__device__ __forceinline__ void n_lru_scan(const Ctx& c0) {
    const Ctx c = fresh(c0); const LV v = make_lv(c);
    const float* a_in = v.tmp; const float* u_in = v.tmp + (size_t)T * 512;
    for (int i = c.gt; i < NB * NCHUNK * 512; i += c.NGT) {
        const int ch = i % 512, bc = i / 512;
        float h = 0.f, P = 1.f;
        for (int j = 0; j < 32; ++j) { const size_t idx = ((size_t)bc * 32 + j) * 512 + ch; const float a = a_in[idx]; h = a * h + u_in[idx]; P *= a; v.hl[idx] = (bf16)f2bf(h); v.pc[idx] = (bf16)f2bf(P); }
        v.aggA[i] = P; v.aggH[i] = h;
    }
}
__device__ __forceinline__ void n_lru_carry(const Ctx& c0) {
    const Ctx c = fresh(c0); const LV v = make_lv(c);
    for (int i = c.gt; i < NB * 512; i += c.NGT) {
        const int b = i / 512, ch = i % 512; float h = 0.f;
        for (int k = 0; k < NCHUNK; ++k) { const size_t idx = ((size_t)b * NCHUNK + k) * 512 + ch; v.carry[idx] = h; h = v.aggA[idx] * h + v.aggH[idx]; }
    }
}
__device__ __forceinline__ void n_merge(const Ctx& c0) {
    const Ctx c = fresh(c0); const LV v = make_lv(c);
    const float* gl = inp(c, 12) + c.l * 512; const float* ga = inp(c, 13) + c.l * 512; const int lane = c.lane;
    for (int t = c.gw; t < T; t += c.NGW) {
        float yl[8], ya[8]; float s1 = 0.f, s2 = 0.f;
#pragma unroll
        for (int j = 0; j < 8; ++j) { const int ch = c.lane + 64 * j; const size_t idx = (size_t)t * 512 + ch;
            const float h = bf2f(v.hl[idx]) + bf2f(v.pc[idx]) * v.carry[(size_t)(t / 32) * 512 + ch];
            yl[j] = h * bf2f(v.gg[idx]); s1 += yl[j] * yl[j];
            const int hd = ch / 64; float num = 0.f, den = 0.f;
#pragma unroll
            for (int br = 0; br < 3; ++br) { const float l = v.lbr[(size_t)br * T * 8 + (size_t)t * 8 + hd]; num += l * bf2f(v.obr[(size_t)br * T * 512 + idx]); den += l; }
            ya[j] = num / den; s2 += ya[j] * ya[j]; }
        s1 = wave_sum(s1, lane); s2 = wave_sum(s2, lane);
        const float r1 = 1.f / sqrtf(s1 * (1.f / 512.f) + EPS), r2 = 1.f / sqrtf(s2 * (1.f / 512.f) + EPS);
#pragma unroll
        for (int j = 0; j < 8; ++j) { const int ch = c.lane + 64 * j;
            v.merged[(size_t)t * 1024 + ch] = (bf16)f2bf(yl[j] * r1 * gl[ch]); v.merged[(size_t)t * 1024 + 512 + ch] = (bf16)f2bf(ya[j] * r2 * ga[ch]); }
    }
}
__device__ __forceinline__ void n_router(const Ctx& c0) {
    const Ctx c = fresh(c0); const LV v = make_lv(c);
    const float* bg = inp(c, 17) + c.l * 4; const float* be = inp(c, 19) + c.l * 32;
    LAS float* lg = (LAS float*)(c.lds + LDS_MISC + 1024 + c.wave * 256);
    const int lane = c.lane;
    for (int t = c.gw; t < T; t += c.NGW) {
        const bf16* xr = v.xb + (size_t)t * 1024;
        float xv[16]; float ss = 0.f;
#pragma unroll
        for (int j = 0; j < 16; ++j) { xv[j] = bf2f(xr[lane + 64 * j]); ss += xv[j] * xv[j]; }
        ss = wave_sum(ss, lane); const float rs = 1.f / sqrtf(ss * (1.f / 1024.f) + EPS);
        for (int col = 0; col < 36; ++col) { float s = 0.f;
#pragma unroll
            for (int j = 0; j < 16; ++j) { const int k = lane + 64 * j; s += xv[j] * (bf2f(v.wr[col * 1024 + k]) + bf2f(v.wr[48 * 1024 + col * 1024 + k])); }
            s = wave_sum(s, lane) * rs + (col < 32 ? be[col] : bg[col - 32]); if (lane == 0) lg[col] = s; }
        asm volatile("s_waitcnt lgkmcnt(0)" ::: "memory");
        if (lane == 0) {
            v.rstd2[t] = rs;
            int g = 0; float gm = lg[32]; for (int j = 1; j < 4; ++j) if (lg[32 + j] > gm) { gm = lg[32 + j]; g = j; }
            float den = 0.f; for (int j = 0; j < 4; ++j) den += __expf(lg[32 + j] - gm);
            const float ptop = 1.f / den;
            int i1 = 0; float v1 = lg[g * 8]; for (int j = 1; j < 8; ++j) if (lg[g * 8 + j] > v1) { v1 = lg[g * 8 + j]; i1 = j; }
            int i2 = -1; float v2 = -INFINITY; for (int j = 0; j < 8; ++j) if (j != i1 && lg[g * 8 + j] > v2) { v2 = lg[g * 8 + j]; i2 = j; }
            const float e2 = __expf(v2 - v1), w1 = ptop / (1.f + e2), w2 = ptop * e2 / (1.f + e2);
            const int ea = g * 8 + i1, eb = g * 8 + i2;
            const int pa = (int)atomicAdd(&v.counts[ea], 1u), pb = (int)atomicAdd(&v.counts[eb], 1u);
            v.asg_e[2 * t] = ea; v.asg_pos[2 * t] = pa; v.asg_w[2 * t] = w1; v.list[(size_t)ea * T + pa] = 2 * t;
            v.asg_e[2 * t + 1] = eb; v.asg_pos[2 * t + 1] = pb; v.asg_w[2 * t + 1] = w2; v.list[(size_t)eb * T + pb] = 2 * t + 1;
        }
        asm volatile("s_waitcnt lgkmcnt(0)" ::: "memory");
    }
}
__device__ __forceinline__ LAS int* moe_plan(const Ctx& c, const unsigned* counts) {
    LAS int* tstart = (LAS int*)(c.lds + LDS_MISC);
    __syncthreads();
    if (c.tid < 64) {
        const int e = c.tid & 31;
        const int cn = (int)__hip_atomic_load(&counts[e], __ATOMIC_RELAXED, __HIP_MEMORY_SCOPE_AGENT);
        const int tiles = (cn + 255) / 256; int incl = tiles;
#pragma unroll
        for (int o = 1; o < 32; o <<= 1) { const int up = __builtin_amdgcn_ds_bpermute(((c.tid - o) & 63) << 2, incl); if (e >= o) incl += up; }
        if (c.tid < 32) { tstart[e] = incl - tiles; tstart[40 + e] = cn; if (e == 31) tstart[NE] = incl; }
    }
    __syncthreads();
    return tstart;
}
__device__ __forceinline__ LAS int* moe_plan_reuse(const Ctx& c) { __syncthreads(); return (LAS int*)(c.lds + LDS_MISC); }
__device__ __forceinline__ void n_moe_up(const Ctx& c0) {
    const Ctx c = fresh(c0); const LV v = make_lv(c);
    LAS int* tstart = moe_plan(c, v.counts);
    const int lane = c.lane, r16 = lane & 15, q4 = lane >> 4, NT = tstart[NE];
    for (int wv = c.gw; wv < NT * 4 * 16; wv += c.NGW) {
        const int rt64 = wv / 16, jb = wv % 16, rt = rt64 / 4;
        int e = 0; while (tstart[e + 1] <= rt) ++e;
        const int cnt = tstart[40 + e], pos0 = (rt - tstart[e]) * 256 + (rt64 % 4) * 64;
        if (pos0 >= cnt) continue;
        const bf16* W = v.wgu + (size_t)e * 1024 * 1024;
        int tok[4];
#pragma unroll
        for (int i = 0; i < 4; ++i) { int pos = pos0 + i * 16 + r16; if (pos >= cnt) pos = pos0; tok[i] = v.list[(size_t)e * T + pos] >> 1; }
        f32x4 ag[4][2], au[4][2];
#pragma unroll
        for (int i = 0; i < 4; ++i)
#pragma unroll
            for (int j = 0; j < 2; ++j) { ag[i][j] = (f32x4){0.f, 0.f, 0.f, 0.f}; au[i][j] = (f32x4){0.f, 0.f, 0.f, 0.f}; }
        for (int k0 = 0; k0 < 1024; k0 += 32) {
            bf16x8 a[4], bg_[2], bu_[2];
#pragma unroll
            for (int i = 0; i < 4; ++i) a[i] = *(const bf16x8*)(v.xb + (size_t)tok[i] * 1024 + k0 + 8 * q4);
#pragma unroll
            for (int j = 0; j < 2; ++j) { const int col = jb * 32 + j * 16 + r16; bg_[j] = *(const bf16x8*)(W + (size_t)gu_row(col, 0) * 1024 + k0 + 8 * q4); bu_[j] = *(const bf16x8*)(W + (size_t)gu_row(col, 1) * 1024 + k0 + 8 * q4); }
#pragma unroll
            for (int i = 0; i < 4; ++i)
#pragma unroll
                for (int j = 0; j < 2; ++j) { ag[i][j] = __builtin_amdgcn_mfma_f32_16x16x32_bf16(a[i], bg_[j], ag[i][j], 0, 0, 0); au[i][j] = __builtin_amdgcn_mfma_f32_16x16x32_bf16(a[i], bu_[j], au[i][j], 0, 0, 0); }
        }
#pragma unroll
        for (int i = 0; i < 4; ++i)
#pragma unroll
            for (int r = 0; r < 4; ++r) { const int pos = pos0 + i * 16 + 4 * q4 + r; if (pos >= cnt) continue;
                const int tk = v.list[(size_t)e * T + pos] >> 1; const float rs = v.rstd2[tk];
#pragma unroll
                for (int j = 0; j < 2; ++j) { const float g = ag[i][j][r] * rs, u = au[i][j][r] * rs; const float hv = g * sigmoidf_(g) * u;
                    v.hid[(size_t)(tstart[e] * 256 + pos) * 512 + jb * 32 + j * 16 + r16] = (bf16)f2bf(hv); } }
    }
}
__device__ __forceinline__ void n_moe_down(const Ctx& c0) {
    const Ctx c = fresh(c0); const LV v = make_lv(c);
    LAS int* tstart = moe_plan(c, v.counts);
    const int lane = c.lane, r16 = lane & 15, q4 = lane >> 4, NT = tstart[NE];
    for (int wv = c.gw; wv < NT * 4 * 16; wv += c.NGW) {
        const int rt64 = wv / 16, nb = wv % 16, rt = rt64 / 4;
        int e = 0; while (tstart[e + 1] <= rt) ++e;
        const int cnt = tstart[40 + e], pos0 = (rt - tstart[e]) * 256 + (rt64 % 4) * 64;
        if (pos0 >= cnt) continue;
        const bf16* W = v.wd + (size_t)e * 1024 * 512;
        const size_t rowbase = (size_t)tstart[e] * 256;
        f32x4 acc[4][4];
#pragma unroll
        for (int i = 0; i < 4; ++i)
#pragma unroll
            for (int j = 0; j < 4; ++j) acc[i][j] = (f32x4){0.f, 0.f, 0.f, 0.f};
        for (int k0 = 0; k0 < 512; k0 += 32) {
            bf16x8 a[4], b[4];
#pragma unroll
            for (int i = 0; i < 4; ++i) { int pos = pos0 + i * 16 + r16; if (pos >= cnt) pos = pos0; a[i] = *(const bf16x8*)(v.hid + (rowbase + pos) * 512 + k0 + 8 * q4); b[i] = *(const bf16x8*)(W + (size_t)(nb * 64 + i * 16 + r16) * 512 + k0 + 8 * q4); }
#pragma unroll
            for (int i = 0; i < 4; ++i)
#pragma unroll
                for (int j = 0; j < 4; ++j) acc[i][j] = __builtin_amdgcn_mfma_f32_16x16x32_bf16(a[i], b[j], acc[i][j], 0, 0, 0);
        }
#pragma unroll
        for (int i = 0; i < 4; ++i)
#pragma unroll
            for (int r = 0; r < 4; ++r) { const int pos = pos0 + i * 16 + 4 * q4 + r; if (pos >= cnt) continue;
#pragma unroll
                for (int j = 0; j < 4; ++j) v.ys[(rowbase + pos) * 1024 + nb * 64 + j * 16 + r16] = (bf16)f2bf(acc[i][j][r]); }
    }
}
__device__ __forceinline__ void n_combine(const Ctx& c0) {
    const Ctx c = fresh(c0); const LV v = make_lv(c);
    LAS int* tstart = moe_plan(c, v.counts); const int lane = c.lane;
    for (int t = c.gw; t < T; t += c.NGW) {
        const size_t r0 = (size_t)tstart[v.asg_e[2 * t]] * 256 + v.asg_pos[2 * t], r1 = (size_t)tstart[v.asg_e[2 * t + 1]] * 256 + v.asg_pos[2 * t + 1];
        float s = 0.f;
#pragma unroll
        for (int j = 0; j < 16; ++j) { const int col = c.lane + 64 * j; const size_t i = (size_t)t * 1024 + col;
            const float val = bf2f(v.xb[i]) + v.asg_w[2 * t] * bf2f(v.ys[r0 * 1024 + col]) + v.asg_w[2 * t + 1] * bf2f(v.ys[r1 * 1024 + col]); if (c.l == DEPTH - 1) v.x[i] = val; else v.xb[i] = (bf16)f2bf(val); s += val * val; }
        s = wave_sum(s, lane);
        if (c.lane == 0) v.rstd1[t] = 1.f / sqrtf(s * (1.f / 1024.f) + EPS);
    }
}

namespace pg8 {
constexpr int BM = 256, BK = 64, HALF = 128, HTB = HALF * BK * 2, STAGE_BYTES = 8 * HTB, NXCD = 8, WGM = 8;
__device__ __forceinline__ int lds_byte(int r, int c) { const int st = (r >> 4) * 2 + (c >> 5), rr = r & 15, cc = c & 31, ob = rr * 64 + cc * 2; return st * 1024 + (ob ^ (((ob >> 9) & 1) << 5)); }
__device__ __forceinline__ void stage_rc(int b, int& R, int& C) { const int st = b / 1024, sb = b % 1024, swz = sb ^ (((sb >> 9) & 1) << 5); R = (st >> 1) * 16 + swz / 64; C = (st & 1) * 32 + (swz % 64) / 2; }
__device__ __forceinline__ int perm32(int rho) { const int n = rho >> 4, i = rho & 15; return 8 * (i >> 2) + 4 * n + (i & 3); }
struct Unit { int pm, pn, e, pos0, cnt; };
__host__ __device__ __forceinline__ size_t hid_off(size_t R, int c) { return (R >> 4) * 8192 + (size_t)((c >> 5) * 512 + (int)(R & 7) * 64 + (int)((R >> 3) & 1) * 32 + (c & 31)); }
__device__ __forceinline__ unsigned cvt_pk_bf16(float lo, float hi) { return pk2(lo, hi); }

__device__ __forceinline__ bool order_next(int i, int G, int c, int nM, int nN, int& pm, int& pn) {
    const int nwg = nM * nN; const long L = (long)i * G + c; if (L >= nwg) return false;
    int wgid = (int)L; { const int q = nwg / NXCD, r = nwg % NXCD, xcd = wgid % NXCD, off = wgid / NXCD; wgid = (xcd < r ? xcd * (q + 1) : r * (q + 1) + (xcd - r) * q) + off; }
    const int nig = WGM * nN, gid = wgid / nig, fm = gid * WGM, gsz = (nM - fm) < WGM ? (nM - fm) : WGM;
    pm = fm + ((wgid % nig) % gsz); pn = (wgid % nig) / gsz; return true;
}
struct DenseSched {
    static constexpr bool GATHER = false, APAIR = false;
    const char* A; const char* Bt; int nM, nN, K, G, c;
    __device__ __forceinline__ bool next(int i, Unit& u) const { u.e = 0; u.pos0 = 0; u.cnt = 0; return order_next(i, G, c, nM, nN, u.pm, u.pn); }
    __device__ __forceinline__ const char* abase(const Unit& u) const { return A + (size_t)u.pm * 256 * K * 2; }
    __device__ __forceinline__ const char* bbase(const Unit& u) const { return Bt + (size_t)u.pn * 256 * K * 2; }
    __device__ __forceinline__ void aoff(const Unit&, int, unsigned (&)[2][2], const int (&)[2], const int (&)[2]) const {}
};
constexpr int MOE_UMAX = 11, LDS_UTAB = 131072, LDS_TOKTAB = LDS_UTAB + 512;
static_assert(LDS_TOKTAB + MOE_UMAX * 1024 <= LDS_MISC && MOE_UMAX * 32 <= 512, "MoE unit cache LDS map");
template <bool GATHER_> struct MoeSched {
    static constexpr bool GATHER = GATHER_, APAIR = !GATHER_;
    const char* A; const char* W; const int* list; const unsigned* counts; LAS int* tstart; int K, G, c; LAS int* utab; LAS int* toktab;
    __device__ __forceinline__ bool unit_of(int i, int& pm, int& pn, int& e, int& pos0, int& cnt) const {
        const int NT = tstart[NE];
        if (!order_next(i, G, c, NT, 4, pm, pn)) return false;
        e = 0; while (tstart[e + 1] <= pm) ++e;
        pos0 = (pm - tstart[e]) * 256; cnt = tstart[40 + e]; return true;
    }
    __device__ __forceinline__ void fill_cache(int tid) const {
        if (tid < MOE_UMAX) { int pm = 0, pn = 0, e = 0, pos0 = 0, cnt = 0; const bool ok = unit_of(tid, pm, pn, e, pos0, cnt);
            LAS int* d = utab + tid * 8; d[0] = pm; d[1] = pn; d[2] = e; d[3] = pos0; d[4] = cnt; d[5] = ok ? 1 : 0; }
        __syncthreads();
        if constexpr (GATHER) {
            constexpr int NJ = (MOE_UMAX * 256 + NTHREADS - 1) / NTHREADS; int tk[NJ];
#pragma unroll
            for (int j = 0; j < NJ; ++j) { const int idx = tid + NTHREADS * j; tk[j] = 0;
                if (idx < MOE_UMAX * 256) { const LAS int* d = utab + (idx >> 8) * 8;
                    if (d[5]) { int pos = d[3] + (idx & 255); if (pos >= d[4]) pos = d[3]; tk[j] = list[(size_t)d[2] * T + pos]; } } }
#pragma unroll
            for (int j = 0; j < NJ; ++j) { const int idx = tid + NTHREADS * j; if (idx < MOE_UMAX * 256) toktab[idx] = tk[j] >> 1; }
            __syncthreads();
        }
    }
    __device__ __forceinline__ bool next(int i, Unit& u) const {
        if (i < MOE_UMAX) { const LAS int* d = utab + i * 8;
            if (!__builtin_amdgcn_readfirstlane(d[5])) return false;
            u.pm = __builtin_amdgcn_readfirstlane(d[0]); u.pn = __builtin_amdgcn_readfirstlane(d[1]); u.e = __builtin_amdgcn_readfirstlane(d[2]);
            u.pos0 = __builtin_amdgcn_readfirstlane(d[3]); u.cnt = __builtin_amdgcn_readfirstlane(d[4]); return true; }
        const int NT = __builtin_amdgcn_readfirstlane(tstart[NE]);
        if (!order_next(i, G, c, NT, 4, u.pm, u.pn)) return false;
        int e = 0; while (__builtin_amdgcn_readfirstlane(tstart[e + 1]) <= u.pm) ++e;
        u.e = e; u.pos0 = (u.pm - __builtin_amdgcn_readfirstlane(tstart[e])) * 256; u.cnt = __builtin_amdgcn_readfirstlane(tstart[40 + e]); return true;
    }
    __device__ __forceinline__ const char* abase(const Unit& u) const { return GATHER ? A : A + (size_t)u.pm * 256 * K * 2; }
    __device__ __forceinline__ const char* bbase(const Unit& u) const { return W + ((size_t)u.e * 1024 + (size_t)u.pn * 256) * K * 2; }
    __device__ __forceinline__ void aoff(const Unit& u, int ui, unsigned (&ao)[2][2], const int (&R)[2], const int (&C)[2]) const {
        if (ui < MOE_UMAX) {
#pragma unroll
            for (int h = 0; h < 2; ++h)
#pragma unroll
                for (int i = 0; i < 2; ++i) { const int tok = toktab[ui * 256 + h * 128 + R[i]]; ao[h][i] = (unsigned)(tok * 1024 + C[i]) * 2u; }
        } else {
#pragma unroll
            for (int h = 0; h < 2; ++h)
#pragma unroll
                for (int i = 0; i < 2; ++i) { int pos = u.pos0 + h * 128 + R[i]; if (pos >= u.cnt) pos = u.pos0; const int tok = list[(size_t)u.e * T + pos] >> 1; ao[h][i] = (unsigned)(tok * 1024 + C[i]) * 2u; }
        }
    }
};

template <class Epi, class Sched>
__device__ __forceinline__ void gemm_phase(LAS unsigned char* lds, const Sched& S, const Epi& E) {
    int tid = threadIdx.x; asm volatile("" : "+v"(tid));
    const int wid = __builtin_amdgcn_readfirstlane(tid >> 6), lane = tid & 63, wr = wid >> 2, wc = wid & 3, fr = lane & 15, fq = lane >> 4;
    const int K = S.K, nt = K / BK;
    constexpr bool GATHER = Sched::GATHER;
    int Rr[2], Cc[2]; unsigned voffA[2], voffB[2];
#pragma unroll
    for (int i = 0; i < 2; ++i) { int R, C; stage_rc(tid * 16 + i * 8192, R, C); const int Rb = Epi::PERM ? ((R & ~31) + perm32(R & 31)) : R; Rr[i] = R; Cc[i] = C;
        voffA[i] = Sched::APAIR ? (unsigned)hid_off((size_t)R, C) * 2u : (unsigned)(R * K + C) * 2u; voffB[i] = (unsigned)(Rb * K + C) * 2u; }
    const size_t kstep = (size_t)(BK * 2);
    const size_t kstepA = Sched::APAIR ? (size_t)(2 * 512 * 2) : kstep;
    const size_t hstep = (size_t)HALF * K * 2;
    const unsigned ldsw = (unsigned)wid * 1024u;
    const int aoff_l = lds_byte(wr * 64 + fr, fq * 8), boff_l = lds_byte(wc * 32 + fr, fq * 8);
#define PG8_SA(b, h) (((b) * 2 + (h)) * HTB)
#define PG8_SB(b, h) ((4 + (b) * 2 + (h)) * HTB)
#define PG8_STAGE_B(bufoff, gbase) do { _Pragma("unroll") for (int _i = 0; _i < 2; ++_i) \
        __builtin_amdgcn_global_load_lds((const unsigned*)((const char*)(gbase) + voffB[_i]), (LAS unsigned*)(lds + (bufoff) + ldsw + _i * 8192), 16, 0, 0); } while (0)
#define PG8_STAGE_A(bufoff, gbase, h, AO) do { _Pragma("unroll") for (int _i = 0; _i < 2; ++_i) \
        __builtin_amdgcn_global_load_lds((const unsigned*)(GATHER ? (const char*)(gbase) + (AO)[h][_i] : (const char*)(gbase) + (h) * hstep + voffA[_i]), (LAS unsigned*)(lds + (bufoff) + ldsw + _i * 8192), 16, 0, 0); } while (0)
#define PG8_LDA(dst, b, h) do { _Pragma("unroll") for (int m = 0; m < 4; ++m) _Pragma("unroll") for (int k = 0; k < 2; ++k) dst[m][k] = *(const LAS bf16x8*)(lds + PG8_SA(b, h) + aoff_l + m * 2048 + k * 1024); } while (0)
#define PG8_LDB(dst, b, h) do { _Pragma("unroll") for (int n = 0; n < 2; ++n) _Pragma("unroll") for (int k = 0; k < 2; ++k) dst[n][k] = *(const LAS bf16x8*)(lds + PG8_SB(b, h) + boff_l + n * 2048 + k * 1024); } while (0)
#define PG8_MMA(ai, bj, At, Bt) do { __builtin_amdgcn_s_setprio(1); _Pragma("unroll") for (int m = 0; m < 4; ++m) _Pragma("unroll") for (int n = 0; n < 2; ++n) _Pragma("unroll") for (int k = 0; k < 2; ++k) \
        acc[ai][bj][m][n] = __builtin_amdgcn_mfma_f32_16x16x32_bf16(Bt[n][k], At[m][k], acc[ai][bj][m][n], 0, 0, 0); __builtin_amdgcn_s_setprio(0); } while (0)
#define PG8_WAIT_V(n) asm volatile("s_waitcnt vmcnt(" #n ")" ::: "memory")
#define PG8_WAIT_L(n) asm volatile("s_waitcnt lgkmcnt(" #n ")" ::: "memory")
#define PG8_BAR __builtin_amdgcn_s_barrier()
#define PG8_SCHED __builtin_amdgcn_sched_barrier(0)
    Unit cur, nxt; int ui = 0;
    if (!S.next(0, cur)) return;
    f32x4 acc[2][2][4][2];
#pragma unroll
    for (int a = 0; a < 2; ++a)
#pragma unroll
        for (int b = 0; b < 2; ++b)
#pragma unroll
            for (int m = 0; m < 4; ++m)
#pragma unroll
                for (int n = 0; n < 2; ++n) acc[a][b][m][n] = (f32x4){0.f, 0.f, 0.f, 0.f};
    bf16x8 At[4][2], B0[2][2], B1[2][2];
    unsigned aoC[2][2], aoN[2][2];
    if constexpr (GATHER) S.aoff(cur, 0, aoC, Rr, Cc);
    const char* cA = S.abase(cur);
    const char* cB = S.bbase(cur);
    PG8_STAGE_B(PG8_SB(0, 0), cB); PG8_STAGE_B(PG8_SB(0, 1), cB + hstep); PG8_STAGE_A(PG8_SA(0, 0), cA, 0, aoC); PG8_STAGE_A(PG8_SA(0, 1), cA, 1, aoC);
    if (wr == 1) PG8_BAR;
    PG8_WAIT_V(2); PG8_BAR;
    PG8_STAGE_B(PG8_SB(1, 0), cB + kstep); PG8_STAGE_A(PG8_SA(1, 0), cA + kstepA, 0, aoC); PG8_STAGE_B(PG8_SB(1, 1), cB + hstep + kstep);
    PG8_WAIT_V(6); PG8_BAR;
    for (;;) {
        const bool has_next = S.next(ui + 1, nxt);
        const char* nA = has_next ? S.abase(nxt) : cA; const char* nB = has_next ? S.bbase(nxt) : cB;
        if constexpr (GATHER) {
            if (has_next) S.aoff(nxt, ui + 1, aoN, Rr, Cc);
            else {
#pragma unroll
                for (int h = 0; h < 2; ++h)
#pragma unroll
                    for (int i = 0; i < 2; ++i) aoN[h][i] = aoC[h][i];
            }
        }
        for (int t = 0; t < nt; t += 2) {
            const bool last = (t == nt - 2);
            const char* a1 = cA + (size_t)(t + 1) * kstepA;
            const char* a2 = last ? nA : cA + (size_t)(t + 2) * kstepA; const char* b2 = last ? nB : cB + (size_t)(t + 2) * kstep;
            const char* a3 = a2 + kstepA; const char* b3 = b2 + kstep;
            unsigned ao2[2][2];
            if constexpr (GATHER) {
#pragma unroll
                for (int h = 0; h < 2; ++h)
#pragma unroll
                    for (int i = 0; i < 2; ++i) ao2[h][i] = last ? aoN[h][i] : aoC[h][i];
            }
            PG8_LDB(B0, 0, 0); PG8_LDB(B1, 0, 1); PG8_SCHED; PG8_LDA(At, 0, 0); PG8_STAGE_A(PG8_SA(1, 1), a1, 1, aoC);
            PG8_WAIT_V(8); PG8_WAIT_L(0); PG8_BAR; PG8_MMA(0, 0, At, B0); PG8_MMA(0, 1, At, B1); PG8_BAR; PG8_SCHED;
            PG8_LDA(At, 0, 1); PG8_STAGE_B(PG8_SB(0, 0), b2); PG8_STAGE_B(PG8_SB(0, 1), b2 + hstep); PG8_STAGE_A(PG8_SA(0, 0), a2, 0, ao2);
            PG8_WAIT_V(8); PG8_WAIT_L(0); PG8_BAR; PG8_MMA(1, 0, At, B0); PG8_MMA(1, 1, At, B1); PG8_BAR; PG8_SCHED;
            PG8_LDB(B0, 1, 0); PG8_LDB(B1, 1, 1); PG8_SCHED; PG8_LDA(At, 1, 0); PG8_STAGE_A(PG8_SA(0, 1), a2, 1, ao2);
            PG8_WAIT_V(8); PG8_WAIT_L(0); PG8_BAR; PG8_MMA(0, 0, At, B0); PG8_MMA(0, 1, At, B1); PG8_BAR; PG8_SCHED;
            PG8_LDA(At, 1, 1); PG8_STAGE_B(PG8_SB(1, 0), b3); PG8_STAGE_B(PG8_SB(1, 1), b3 + hstep); PG8_STAGE_A(PG8_SA(1, 0), a3, 0, ao2);
            PG8_WAIT_V(8); PG8_WAIT_L(0); PG8_BAR; PG8_MMA(1, 0, At, B0); PG8_MMA(1, 1, At, B1); PG8_BAR; PG8_SCHED;
        }
        if (wr == 0) PG8_BAR;
        E(acc, cur, wr, wc, fr, fq);
        if (!has_next) break;
#pragma unroll
        for (int a = 0; a < 2; ++a)
#pragma unroll
            for (int b = 0; b < 2; ++b)
#pragma unroll
                for (int m = 0; m < 4; ++m)
#pragma unroll
                    for (int n = 0; n < 2; ++n) acc[a][b][m][n] = (f32x4){0.f, 0.f, 0.f, 0.f};
        cur = nxt; cA = nA; cB = nB; ++ui;
        if constexpr (GATHER) {
#pragma unroll
            for (int h = 0; h < 2; ++h)
#pragma unroll
                for (int i = 0; i < 2; ++i) aoC[h][i] = aoN[h][i];
        }
        if (wr == 1) PG8_BAR;
    }
    PG8_WAIT_V(0);
    PG8_BAR;
#undef PG8_SA
#undef PG8_SB
#undef PG8_STAGE_A
#undef PG8_STAGE_B
#undef PG8_LDA
#undef PG8_LDB
#undef PG8_MMA
#undef PG8_WAIT_V
#undef PG8_WAIT_L
#undef PG8_BAR
#undef PG8_SCHED
}

__device__ __forceinline__ unsigned ror8(unsigned v) { return (unsigned)__builtin_amdgcn_update_dpp(0, (int)v, 0x128, 0xF, 0xF, false); }
__device__ __forceinline__ void store_patch(bf16* p, size_t pitch, u32x4 w0, u32x4 w1, int fr, int fq) {
    const bool lo = fr < 8;
    u32x4 r; r.x = ror8(lo ? w1.x : w0.x); r.y = ror8(lo ? w1.y : w0.y); r.z = ror8(lo ? w1.z : w0.z); r.w = ror8(lo ? w1.w : w0.w);
    u32x4 d1, d2; d1.x = lo ? w0.x : r.x; d1.y = lo ? w0.y : r.y; d1.z = lo ? w0.z : r.z; d1.w = lo ? w0.w : r.w;
    d2.x = lo ? r.x : w1.x; d2.y = lo ? r.y : w1.y; d2.z = lo ? r.z : w1.z; d2.w = lo ? r.w : w1.w;
    bf16* q = p + (size_t)(fr & 7) * pitch + (lo ? 0 : 32) + 8 * fq;
    *(u32x4*)q = d1; *(u32x4*)(q + 8 * pitch) = d2;
}
struct EpiProj {
    static constexpr bool PERM = true;
    const float* rstd; bf16* base5;
    const float *qg, *kg;
    __device__ __forceinline__ void operator()(const f32x4 (&acc)[2][2][4][2], const Unit& u_, int wr, int wc, int fr_, int fq_) const {
        int fr = fr_, fq = fq_; asm volatile("" : "+v"(fr), "+v"(fq));
        Unit u = u_; asm volatile("" : "+s"(u.pm), "+s"(u.pn)); const int lane = fq * 16 + fr;
        const int sec = u.pn >> 1, half = u.pn & 1, row0 = u.pm * BM + wr * 64;
        bf16* dstp = base5 + (size_t)sec * ((size_t)T * 512) + half * 256 + wc * 64;
        float rsv[8];
#pragma unroll
        for (int ai = 0; ai < 2; ++ai)
#pragma unroll
            for (int m = 0; m < 4; ++m) rsv[ai * 4 + m] = rstd[row0 + ai * HALF + m * 16 + fr];
        f32x4 g[2][2];
        { const float* gp = qg + (sec == 3 ? (kg - qg) : 0);
#pragma unroll
          for (int bj = 0; bj < 2; ++bj)
#pragma unroll
              for (int n = 0; n < 2; ++n) g[bj][n] = *(const f32x4*)(gp + 32 * bj + 8 * fq + 4 * n); }
        if (sec == 2 || sec == 3) {
            const float sc = sec == 2 ? QSCALE : 1.f;
#pragma unroll
            for (int bj = 0; bj < 2; ++bj)
#pragma unroll
                for (int n = 0; n < 2; ++n) g[bj][n] = g[bj][n] * sc;
#pragma unroll
            for (int ai = 0; ai < 2; ++ai)
#pragma unroll
                for (int m = 0; m < 4; ++m) { const int rowb = row0 + ai * HALF + m * 16; const float rs = rsv[ai * 4 + m];
                    f32x4 val[2][2]; float ss = 0.f;
#pragma unroll
                    for (int bj = 0; bj < 2; ++bj)
#pragma unroll
                        for (int n = 0; n < 2; ++n) { const f32x4 t = acc[ai][bj][m][n] * rs; val[bj][n] = t; ss += (t[0] * t[0] + t[1] * t[1]) + (t[2] * t[2] + t[3] * t[3]); }
                    ss += shx(ss, lane, 16); ss += shx(ss, lane, 32);
                    const float r = frsq(ss * (1.f / 64.f) + EPS);
                    u32x4 w[2];
#pragma unroll
                    for (int bj = 0; bj < 2; ++bj) { const f32x4 v0 = val[bj][0] * r * g[bj][0], v1 = val[bj][1] * r * g[bj][1];
                        w[bj].x = cvt_pk_bf16(v0[0], v0[1]); w[bj].y = cvt_pk_bf16(v0[2], v0[3]); w[bj].z = cvt_pk_bf16(v1[0], v1[1]); w[bj].w = cvt_pk_bf16(v1[2], v1[3]); }
                    store_patch(dstp + (size_t)rowb * 512, 512, w[0], w[1], fr, fq); }
        } else {
#pragma unroll
            for (int ai = 0; ai < 2; ++ai)
#pragma unroll
                for (int m = 0; m < 4; ++m) { const int rowb = row0 + ai * HALF + m * 16; const float rs = rsv[ai * 4 + m];
                    u32x4 w[2];
#pragma unroll
                    for (int bj = 0; bj < 2; ++bj) { f32x4 v0 = acc[ai][bj][m][0] * rs, v1 = acc[ai][bj][m][1] * rs;
                        if (sec == 1) { v0 = (f32x4){gelu_tanh(v0[0]), gelu_tanh(v0[1]), gelu_tanh(v0[2]), gelu_tanh(v0[3])}; v1 = (f32x4){gelu_tanh(v1[0]), gelu_tanh(v1[1]), gelu_tanh(v1[2]), gelu_tanh(v1[3])}; }
                        w[bj].x = cvt_pk_bf16(v0[0], v0[1]); w[bj].y = cvt_pk_bf16(v0[2], v0[3]); w[bj].z = cvt_pk_bf16(v1[0], v1[1]); w[bj].w = cvt_pk_bf16(v1[2], v1[3]); }
                    store_patch(dstp + (size_t)rowb * 512, 512, w[0], w[1], fr, fq); }
        }
    }
};
struct EpiOut {
    static constexpr bool PERM = true;
    const bf16* xi; bf16* xo;
    __device__ __forceinline__ void operator()(const f32x4 (&acc)[2][2][4][2], const Unit& u_, int wr, int wc, int fr_, int fq_) const {
        int fr = fr_, fq = fq_; asm volatile("" : "+v"(fr), "+v"(fq));
        Unit u = u_; asm volatile("" : "+s"(u.pm), "+s"(u.pn));
        const int colp = u.pn * BM + wc * 64;
        const bool lo = fr < 8; const size_t lanecol = (size_t)colp + (lo ? 0 : 32) + 8 * fq;
        u32x4 old1[8], old2[8];
#pragma unroll
        for (int ai = 0; ai < 2; ++ai)
#pragma unroll
            for (int m = 0; m < 4; ++m) { const size_t rowb = (size_t)(u.pm * BM + ai * HALF + wr * 64 + m * 16);
                const bf16* q = xi + (rowb + (fr & 7)) * 1024 + lanecol; old1[ai * 4 + m] = *(const u32x4*)q; old2[ai * 4 + m] = *(const u32x4*)(q + 8 * 1024); }
#pragma unroll
        for (int ai = 0; ai < 2; ++ai)
#pragma unroll
            for (int m = 0; m < 4; ++m) { const size_t rowb = (size_t)(u.pm * BM + ai * HALF + wr * 64 + m * 16);
                const u32x4 o1 = old1[ai * 4 + m], o2 = old2[ai * 4 + m];
                float e1[8], e2[8];
#pragma unroll
                for (int n = 0; n < 2; ++n)
#pragma unroll
                    for (int i = 0; i < 4; ++i) { const float a0 = acc[ai][0][m][n][i], a1 = acc[ai][1][m][n][i];
                        const float r = __builtin_bit_cast(float, ror8(__builtin_bit_cast(unsigned, lo ? a1 : a0)));
                        e1[4 * n + i] = lo ? a0 : r; e2[4 * n + i] = lo ? r : a1; }
                u32x4 d1, d2;
                d1.x = cvt_pk_bf16(bf2f(o1.x & 0xffffu) + e1[0], bf2f(o1.x >> 16) + e1[1]); d1.y = cvt_pk_bf16(bf2f(o1.y & 0xffffu) + e1[2], bf2f(o1.y >> 16) + e1[3]);
                d1.z = cvt_pk_bf16(bf2f(o1.z & 0xffffu) + e1[4], bf2f(o1.z >> 16) + e1[5]); d1.w = cvt_pk_bf16(bf2f(o1.w & 0xffffu) + e1[6], bf2f(o1.w >> 16) + e1[7]);
                d2.x = cvt_pk_bf16(bf2f(o2.x & 0xffffu) + e2[0], bf2f(o2.x >> 16) + e2[1]); d2.y = cvt_pk_bf16(bf2f(o2.y & 0xffffu) + e2[2], bf2f(o2.y >> 16) + e2[3]);
                d2.z = cvt_pk_bf16(bf2f(o2.z & 0xffffu) + e2[4], bf2f(o2.z >> 16) + e2[5]); d2.w = cvt_pk_bf16(bf2f(o2.w & 0xffffu) + e2[6], bf2f(o2.w >> 16) + e2[7]);
                bf16* qo = xo + (rowb + (fr & 7)) * 1024 + lanecol;
                *(u32x4*)qo = d1; *(u32x4*)(qo + 8 * 1024) = d2; }
    }
};
struct EpiUp {
    static constexpr bool PERM = true;
    const float* rsl; bf16* hid;
    __device__ __forceinline__ void operator()(const f32x4 (&acc)[2][2][4][2], const Unit& u_, int wr, int wc, int fr_, int fq_) const {
        int fr = fr_, fq = fq_; asm volatile("" : "+v"(fr), "+v"(fq));
        Unit u = u_; asm volatile("" : "+s"(u.pos0), "+s"(u.pm));
        bf16* dst = hid + hid_off((size_t)(u.pm * BM) + wr * 64 + fr, u.pn * 128 + wc * 32 + 8 * fq);
        float rsv[8];
#pragma unroll
        for (int ai = 0; ai < 2; ++ai)
#pragma unroll
            for (int m = 0; m < 4; ++m) { const int rl = ai * HALF + wr * 64 + m * 16 + fr; int pos = u.pos0 + rl; if (pos >= u.cnt) pos = u.pos0; rsv[ai * 4 + m] = rsl[(size_t)u.e * T + pos]; }
#pragma unroll
        for (int ai = 0; ai < 2; ++ai)
#pragma unroll
            for (int m = 0; m < 4; ++m) { const int rl = ai * HALF + wr * 64 + m * 16 + fr;
                const float rs = rsv[ai * 4 + m];
                float h[8];
#pragma unroll
                for (int n = 0; n < 2; ++n)
#pragma unroll
                    for (int i = 0; i < 4; ++i) { const float g = acc[ai][0][m][n][i] * rs, up = acc[ai][1][m][n][i] * rs; h[4 * n + i] = g * up * frcp(1.f + fexp(-g)); }
                u32x4 w; w.x = cvt_pk_bf16(h[0], h[1]); w.y = cvt_pk_bf16(h[2], h[3]); w.z = cvt_pk_bf16(h[4], h[5]); w.w = cvt_pk_bf16(h[6], h[7]);
                *(u32x4*)(dst + (size_t)(ai * 8 + m) * 8192) = w; }
    }
};
constexpr float YS_SCALE = 16.f;
__device__ __forceinline__ float sat8(float x) { return __builtin_amdgcn_fmed3f(x, -448.f, 448.f); }
__device__ __forceinline__ unsigned pk4_fp8(float a, float b, float c2, float d) { a = sat8(a); b = sat8(b); c2 = sat8(c2); d = sat8(d); int w = 0; w = __builtin_amdgcn_cvt_pk_fp8_f32(a, b, w, false); w = __builtin_amdgcn_cvt_pk_fp8_f32(c2, d, w, true); return (unsigned)w; }
struct EpiDown {
    static constexpr bool PERM = true;
    unsigned char* ys;
    __device__ __forceinline__ void operator()(const f32x4 (&acc)[2][2][4][2], const Unit& u_, int wr, int wc, int fr_, int fq_) const {
        int fr = fr_, fq = fq_; asm volatile("" : "+v"(fr), "+v"(fq));
        Unit u = u_; asm volatile("" : "+s"(u.pos0), "+s"(u.pm));
        unsigned char* dst = ys + (size_t)(u.pm * BM + wr * 64 + fr) * 1024 + u.pn * BM + wc * 64 + 16 * fq;
#pragma unroll
        for (int ai = 0; ai < 2; ++ai)
#pragma unroll
            for (int m = 0; m < 4; ++m) { const int rl = ai * HALF + m * 16;
                const f32x4 a0 = acc[ai][0][m][0] * YS_SCALE, a1 = acc[ai][0][m][1] * YS_SCALE, b0 = acc[ai][1][m][0] * YS_SCALE, b1 = acc[ai][1][m][1] * YS_SCALE;
                u32x4 w; w.x = pk4_fp8(a0[0], a0[1], a0[2], a0[3]); w.y = pk4_fp8(a1[0], a1[1], a1[2], a1[3]); w.z = pk4_fp8(b0[0], b0[1], b0[2], b0[3]); w.w = pk4_fp8(b1[0], b1[1], b1[2], b1[3]);
                *(u32x4*)(dst + (size_t)rl * 1024) = w; }
    }
};
}

namespace attn {
typedef float f32x16 __attribute__((ext_vector_type(16)));
typedef short s16x4 __attribute__((ext_vector_type(4)));
constexpr int KSTR = 6176;
constexpr int LK = 0, LVV = 8 * KSTR, VSTR = 24576 + 128, LO = LVV + 2 * VSTR;
constexpr float OBR_SCALE = 16.f;
constexpr int OPITCH = 144, OSTG = 32 * OPITCH;
static_assert(LO + 8 * OSTG <= LDS_MISC, "attention LDS map");
__device__ __forceinline__ int crow(int r, int hi) { return (r & 3) + 8 * (r >> 2) + 4 * hi; }
__device__ __forceinline__ s16x4 vtr(const LAS unsigned char* p) { return __builtin_bit_cast(s16x4, __builtin_amdgcn_ds_read_tr16_b64_v4i16((LAS s16x4*)p)); }
__device__ __forceinline__ unsigned cvtpk(float lo, float hi) { return pk2(lo, hi); }

__device__ __forceinline__ void phase(const Ctx& c0) {
    const Ctx c = fresh(c0); const LV v = make_lv(c);
    const int lane = c.lane, w = c.wave, r32 = lane & 31, hi = lane >> 5;
    LAS unsigned char* lds = c.lds;
    u32x4 kreg[6], vreg[6]; bf16x8 qr[4];
    unsigned bm0[8], bm4[8];
#pragma unroll
    for (int i = 0; i < 8; ++i) { const int k0 = crow(2 * i, hi), k1 = k0 + 1;
        bm0[i] = (k0 >= r32 ? 0xffffu : 0u) | (k1 >= r32 ? 0xffff0000u : 0u); bm4[i] = (k0 <= r32 ? 0xffffu : 0u) | (k1 <= r32 ? 0xffff0000u : 0u); }
    const bf16x8 ones = (bf16x8){(short)0x3f80, (short)0x3f80, (short)0x3f80, (short)0x3f80, (short)0x3f80, (short)0x3f80, (short)0x3f80, (short)0x3f80};
#define ATT_DECODE(U_) const int b = (U_) / 384, rem = (U_) % 384, h = rem / 48, rem2 = rem % 48, br = rem2 >> 4, u16 = rem2 & 15; \
        const int dsh = 2 * br, d = 1 << dsh, r = u16 & (d - 1), nb = u16 >> dsh; const int i0 = 256 * nb - 128; const size_t tokbase = (size_t)b * SEQ;
#define ATT_LOAD_KV(J0_, J1_) do { _Pragma("unroll") for (int j = (J0_); j < (J1_); ++j) { const int p = c.tid + 512 * j, row = p >> 3, ch = p & 7, idx = ni0 + row; \
            const size_t tok = ntokbase + (size_t)(idx < 0 ? 0 : idx) * nd + nr; kreg[j] = *(const u32x4*)(nkg + tok * 512 + ch * 8); vreg[j] = *(const u32x4*)(nvg + tok * 512 + ch * 8); } } while (0)
#define ATT_LOAD_Q() do { _Pragma("unroll") for (int s2 = 0; s2 < 4; ++s2) { const size_t qtok = ntokbase + (size_t)(256 * nnb + 32 * w + (lane >> 3) + 8 * s2) * nd + nr;     \
            qr[s2] = *(const bf16x8*)(nqg + qtok * 512 + (lane & 7) * 8); } } while (0)
#define ATT_NEXT(U_) { ATT_DECODE(U_) ni0 = i0; nd = d; nr = r; nnb = nb; ntokbase = tokbase; nkg = v.k + h * 64; nvg = v.v + h * 64; nqg = v.q + h * 64; }
    int ni0, nd, nr, nnb; size_t ntokbase; const bf16 *nkg, *nvg, *nqg;
    const int vid = (c.G % 8 == 0) ? (c.bid % 8) * (c.G / 8) + c.bid / 8 : c.bid;
    constexpr int NUNIT = NB * NHEAD * 3 * 16;
    const bool xmap = (c.G == 256); const int xj = c.bid >> 3, xx = c.bid & 7;
    const int upw = xmap ? NUNIT / 256 : (vid < NUNIT ? (NUNIT - vid + c.G - 1) / c.G : 0);
#define ATT_UID(i_) (xmap ? (((xx * 4 + (i_) / 3) * 2 + (xj >> 4)) * 48 + ((i_) % 3) * 16 + (xj & 15)) : vid + c.G * (i_))
    if (upw > 0) { ATT_NEXT(ATT_UID(0)) ATT_LOAD_KV(0, 6); ATT_LOAD_Q(); }
    for (int iu = 0; iu < upw; ++iu) {
        const int U = ATT_UID(iu);
        ATT_DECODE(U)
#pragma unroll
        for (int j = 0; j < 6; ++j) { const int p = c.tid + 512 * j, row = p >> 3, ch = p & 7;
            *(LAS u32x4*)(lds + LK + ch * KSTR + row * 16) = kreg[j];
            *(LAS u32x4*)(lds + LVV + (ch >> 2) * VSTR + (row >> 4) * 1024 + (row & 15) * 64 + (ch & 3) * 16) = vreg[j]; }
        bf16x8 qc[4];
        { LAS unsigned char* qst = lds + LO + w * OSTG;
#pragma unroll
          for (int j = 0; j < 4; ++j) { const int row = (lane >> 3) + 8 * j; *(LAS bf16x8*)(qst + row * 128 + (((lane & 7) ^ (row & 7)) * 16)) = qr[j]; }
          asm volatile("s_waitcnt lgkmcnt(0)" ::: "memory");
#pragma unroll
          for (int s2 = 0; s2 < 4; ++s2) qc[s2] = *(const LAS bf16x8*)(qst + r32 * 128 + (((2 * s2 + hi) ^ (r32 & 7)) * 16));
          asm volatile("s_waitcnt lgkmcnt(0)" ::: "memory"); }
        ATT_NEXT(ATT_UID(iu + 1 < upw ? iu + 1 : iu))
        ATT_LOAD_Q();
        __syncthreads();
        f32x16 o0 = {}, o1 = {}, lacc = {};
        const LAS unsigned char* vbase = lds + LVV + ((lane >> 4) & 1) * 32 + (lane & 3) * 8 + (4 * hi + ((lane & 15) >> 2)) * 64;
#pragma unroll
        for (int kt = 0; kt < 5; ++kt) {
            ATT_LOAD_KV(kt, kt == 4 ? 6 : kt + 1);
            if (nb == 0 && w + kt < 4) continue;
            const int rr0 = 32 * (w + kt);
            f32x16 p = {};
            __builtin_amdgcn_s_setprio(1);
#pragma unroll
            for (int s2 = 0; s2 < 4; ++s2) { const bf16x8 kf = *(const LAS bf16x8*)(lds + LK + (2 * s2 + hi) * KSTR + (rr0 + r32) * 16); p = __builtin_amdgcn_mfma_f32_32x32x16_bf16(kf, qc[s2], p, 0, 0, 0); }
            __builtin_amdgcn_s_setprio(0);
#pragma unroll
            for (int rI = 0; rI < 16; ++rI) p[rI] = __builtin_amdgcn_exp2f(p[rI]);
            u32x4 pw0, pw1;
            pw0.x = cvtpk(p[0], p[1]); pw0.y = cvtpk(p[2], p[3]); pw0.z = cvtpk(p[4], p[5]); pw0.w = cvtpk(p[6], p[7]);
            pw1.x = cvtpk(p[8], p[9]); pw1.y = cvtpk(p[10], p[11]); pw1.z = cvtpk(p[12], p[13]); pw1.w = cvtpk(p[14], p[15]);
            if (kt == 0) { pw0.x &= bm0[0]; pw0.y &= bm0[1]; pw0.z &= bm0[2]; pw0.w &= bm0[3]; pw1.x &= bm0[4]; pw1.y &= bm0[5]; pw1.z &= bm0[6]; pw1.w &= bm0[7]; }
            if (kt == 4) { pw0.x &= bm4[0]; pw0.y &= bm4[1]; pw0.z &= bm4[2]; pw0.w &= bm4[3]; pw1.x &= bm4[4]; pw1.y &= bm4[5]; pw1.z &= bm4[6]; pw1.w &= bm4[7]; }
            const bf16x8 pa0 = __builtin_bit_cast(bf16x8, pw0), pa1 = __builtin_bit_cast(bf16x8, pw1);
            const LAS unsigned char* vt = vbase + (rr0 >> 4) * 1024;
            __builtin_amdgcn_s_setprio(1);
#pragma unroll
            for (int ks = 0; ks < 2; ++ks) {
                const s16x4 a0 = vtr(vt + ks * 1024), a1 = vtr(vt + ks * 1024 + 512), b0 = vtr(vt + VSTR + ks * 1024), b1 = vtr(vt + VSTR + ks * 1024 + 512);
                const bf16x8 vf0 = (bf16x8){a0[0], a0[1], a0[2], a0[3], a1[0], a1[1], a1[2], a1[3]}, vf1 = (bf16x8){b0[0], b0[1], b0[2], b0[3], b1[0], b1[1], b1[2], b1[3]};
                o0 = __builtin_amdgcn_mfma_f32_32x32x16_bf16(vf0, ks ? pa1 : pa0, o0, 0, 0, 0);
                o1 = __builtin_amdgcn_mfma_f32_32x32x16_bf16(vf1, ks ? pa1 : pa0, o1, 0, 0, 0);
                lacc = __builtin_amdgcn_mfma_f32_32x32x16_bf16(ones, ks ? pa1 : pa0, lacc, 0, 0, 0);
            }
            __builtin_amdgcn_s_setprio(0);
        }
        const float lsum = lacc[0];
        LAS unsigned char* stg = lds + LO + w * OSTG;
        { const float rl = frcp(lsum) * OBR_SCALE;
#pragma unroll
          for (int g = 0; g < 4; ++g) {
              *(LAS unsigned*)(stg + r32 * OPITCH + 8 * g + 4 * hi) = pg8::pk4_fp8(o0[4 * g] * rl, o0[4 * g + 1] * rl, o0[4 * g + 2] * rl, o0[4 * g + 3] * rl);
              *(LAS unsigned*)(stg + r32 * OPITCH + 32 + 8 * g + 4 * hi) = pg8::pk4_fp8(o1[4 * g] * rl, o1[4 * g + 1] * rl, o1[4 * g + 2] * rl, o1[4 * g + 3] * rl); } }
        asm volatile("s_waitcnt lgkmcnt(0)" ::: "memory");
        unsigned char* ob = (unsigned char*)v.obr + (size_t)br * T * 512 + h * 64;
#pragma unroll
        for (int i = 0; i < 2; ++i) { const int row = i * 16 + (lane >> 2), ch = lane & 3; const u32x4 val = *(const LAS u32x4*)(stg + row * OPITCH + ch * 16);
            const size_t tok = tokbase + (size_t)(256 * nb + 32 * w + row) * d + r; *(u32x4*)(ob + tok * 512 + ch * 16) = val; }
        if (hi == 0) { const size_t tok = tokbase + (size_t)(256 * nb + 32 * w + r32) * d + r; v.lbr[(size_t)br * T * 8 + tok * 8 + h] = lsum; }
        __syncthreads();
    }
}
}

namespace lru {
typedef float f32x16 __attribute__((ext_vector_type(16)));
constexpr int L_CW = 0, L_CB = 8192, L_BA = 10240, L_BX = 12288, L_SP = 14336, L_SCR = 16384, SCR_STRIDE = 68, SCR_BYTES = 32 * SCR_STRIDE * 4;
constexpr int L_RAW = L_SCR + 8 * SCR_BYTES, RAW_STRIDE = 144, RAW_BYTES = 5120;
static_assert(L_RAW + 8 * RAW_BYTES <= LDS_MISC && 35 * RAW_STRIDE <= RAW_BYTES, "lru LDS map");
__device__ __forceinline__ int crow(int r, int hi) { return (r & 3) + 8 * (r >> 2) + 4 * hi; }
__device__ __forceinline__ void phase(const Ctx& c0) {
    const Ctx c = fresh(c0); const LV v = make_lv(c);
    const int lane = c.lane, tok = lane & 31, hi = lane >> 5, l = c.l;
    LAS unsigned char* lds = c.lds;
    __syncthreads();
    { const float* cw = inp(c, 3) + l * 2048; const float* cb = inp(c, 4) + l * 512; const float* ba = inp(c, 6) + l * 512; const float* bx = inp(c, 8) + l * 512;
      { float t4[4];
#pragma unroll
        for (int j = 0; j < 4; ++j) t4[j] = cw[c.tid + NTHREADS * j];
#pragma unroll
        for (int j = 0; j < 4; ++j) ((LAS float*)(lds + L_CW))[c.tid + NTHREADS * j] = t4[j]; }
      { const int i = c.tid; ((LAS float*)(lds + L_CB))[i] = cb[i]; ((LAS float*)(lds + L_BA))[i] = ba[i]; ((LAS float*)(lds + L_BX))[i] = bx[i]; ((LAS float*)(lds + L_SP))[i] = v.sp[i]; } }
    __syncthreads();
    LAS float* scr = (LAS float*)(lds + L_SCR + c.wave * SCR_BYTES);
    const int h = c.gw & 7;
    bf16x8 fa[4][2], fx[4][2];
#pragma unroll
    for (int s2 = 0; s2 < 4; ++s2)
#pragma unroll
        for (int nbk = 0; nbk < 2; ++nbk) { const size_t wo = (size_t)(h * 64 + 32 * nbk + tok) * 64 + 16 * s2 + 8 * hi; fa[s2][nbk] = *(const bf16x8*)(v.wat + wo); fx[s2][nbk] = *(const bf16x8*)(v.wxt + wo); }
    LAS unsigned char* rawt = lds + L_RAW + c.wave * RAW_BYTES;
    u32x4 rreg[5];
#define LRU_LOAD(it_) do { const int bc_ = (it_) >> 3, t0_ = bc_ * 32, pos0_ = (bc_ & (NCHUNK - 1)) * 32; \
        _Pragma("unroll") for (int j = 0; j < 5; ++j) { const int p = lane + 64 * j, row = p >> 3, pc8 = p & 7; const bool ok = (row < 35) && (pos0_ + row - 3 >= 0); \
            const u32x4 val = *(const u32x4*)(v.xl + (size_t)(t0_ + (ok ? row - 3 : 0)) * 512 + h * 64 + pc8 * 8); rreg[j] = ok ? val : (u32x4){0u, 0u, 0u, 0u}; } } while (0)
    if (c.gw < NB * NCHUNK * 8) LRU_LOAD(c.gw);
    for (int it = c.gw; it < NB * NCHUNK * 8; it += c.NGW) {
        const int bc = it >> 3, t0 = bc * 32;
#pragma unroll
        for (int j = 0; j < 5; ++j) { const int p = lane + 64 * j, row = p >> 3, pc8 = p & 7; if (row < 35) *(LAS u32x4*)(rawt + row * RAW_STRIDE + pc8 * 16) = rreg[j]; }
        if (it + c.NGW < NB * NCHUNK * 8) LRU_LOAD(it + c.NGW);
        asm volatile("s_waitcnt lgkmcnt(0)" ::: "memory");
        bf16x8 axc[4];
#pragma unroll
        for (int s2 = 0; s2 < 4; ++s2) {
            const int ch0 = h * 64 + 16 * s2 + 8 * hi;
            f32x4 x0 = *(const LAS f32x4*)(lds + L_CB + ch0 * 4), x1 = *(const LAS f32x4*)(lds + L_CB + ch0 * 4 + 16);
#pragma unroll
            for (int tap = 0; tap < 4; ++tap) {
                const u32x4 raw = *(const LAS u32x4*)(rawt + (tok + tap) * RAW_STRIDE + (2 * s2 + hi) * 16);
                const f32x4 w0 = *(const LAS f32x4*)(lds + L_CW + (tap * 512 + ch0) * 4), w1 = *(const LAS f32x4*)(lds + L_CW + (tap * 512 + ch0) * 4 + 16);
                x0[0] += w0[0] * bf2f(raw.x & 0xffffu); x0[1] += w0[1] * bf2f(raw.x >> 16); x0[2] += w0[2] * bf2f(raw.y & 0xffffu); x0[3] += w0[3] * bf2f(raw.y >> 16);
                x1[0] += w1[0] * bf2f(raw.z & 0xffffu); x1[1] += w1[1] * bf2f(raw.z >> 16); x1[2] += w1[2] * bf2f(raw.w & 0xffffu); x1[3] += w1[3] * bf2f(raw.w >> 16);
            }
            *(LAS f32x4*)(scr + tok * SCR_STRIDE + 16 * s2 + 8 * hi) = x0; *(LAS f32x4*)(scr + tok * SCR_STRIDE + 16 * s2 + 8 * hi + 4) = x1;
            u32x4 pk; pk.x = pk2(x0[0], x0[1]); pk.y = pk2(x0[2], x0[3]); pk.z = pk2(x1[0], x1[1]); pk.w = pk2(x1[2], x1[3]);
            axc[s2] = __builtin_bit_cast(bf16x8, pk);
        }
        f32x16 ra[2] = {{}, {}}, rx[2] = {{}, {}};
#pragma unroll
        for (int s2 = 0; s2 < 4; ++s2)
#pragma unroll
            for (int nbk = 0; nbk < 2; ++nbk) {
                ra[nbk] = __builtin_amdgcn_mfma_f32_32x32x16_bf16(axc[s2], fa[s2][nbk], ra[nbk], 0, 0, 0); rx[nbk] = __builtin_amdgcn_mfma_f32_32x32x16_bf16(axc[s2], fx[s2][nbk], rx[nbk], 0, 0, 0); }
#pragma unroll
        for (int nbk = 0; nbk < 2; ++nbk) {
            const int ch = h * 64 + 32 * nbk + tok;
            const float bav = ((const LAS float*)(lds + L_BA))[ch], bxv = ((const LAS float*)(lds + L_BX))[ch], spv = ((const LAS float*)(lds + L_SP))[ch];
            float hl_[16], pl_[16], Hg[4], Ag[4];
            float av[16], uv[16];
            { typedef float f32x2 __attribute__((ext_vector_type(2)));
              constexpr float L2E = 1.4426950408889634f;
              const float nba = -bav * L2E, nbx = -bxv * L2E, c8 = -8.f * spv * L2E;
#pragma unroll
              for (int p2 = 0; p2 < 8; ++p2) { const int r0 = 2 * p2, r1 = r0 + 1;
                  const f32x2 za = (f32x2){ra[nbk][r0], ra[nbk][r1]} * (-L2E) + nba, zx = (f32x2){rx[nbk][r0], rx[nbk][r1]} * (-L2E) + nbx;
                  const f32x2 da = (f32x2){__builtin_amdgcn_exp2f(za.x), __builtin_amdgcn_exp2f(za.y)} + 1.f, dx = (f32x2){__builtin_amdgcn_exp2f(zx.x), __builtin_amdgcn_exp2f(zx.y)} + 1.f;
                  const f32x2 r = {frcp(da.x), frcp(da.y)}, ig = {frcp(dx.x), frcp(dx.y)};
                  const f32x2 la = r * c8; const f32x2 a = {__builtin_amdgcn_exp2f(la.x), __builtin_amdgcn_exp2f(la.y)};
                  const f32x2 t = 1.f - a * a; const f32x2 sq = {fsqrt(fmaxf(t.x, 0.f)), fsqrt(fmaxf(t.y, 0.f))};
                  const f32x2 xc = {scr[crow(r0, hi) * SCR_STRIDE + 32 * nbk + tok], scr[crow(r1, hi) * SCR_STRIDE + 32 * nbk + tok]};
                  const f32x2 u = sq * (ig * xc);
                  av[r0] = a.x; av[r1] = a.y; uv[r0] = u.x; uv[r1] = u.y; } }
#pragma unroll
            for (int g = 0; g < 4; ++g) { float H = 0.f, P = 1.f;
#pragma unroll
                for (int i = 0; i < 4; ++i) { const int rI = 4 * g + i; H = av[rI] * H + uv[rI]; P *= av[rI]; hl_[rI] = H; pl_[rI] = P; }
                Hg[g] = H; Ag[g] = P; }
            float ch_ = 0.f, cp_ = 1.f, oh = 0.f, op = 1.f;
#pragma unroll
            for (int g = 0; g < 4; ++g) {
                float in_h = ch_, in_p = cp_; oh = Ag[g] * in_h + Hg[g]; op = in_p * Ag[g];
                const float x_h = shx(oh, lane, 32), x_p = shx(op, lane, 32);
                if (hi) { in_h = x_h; in_p = x_p; oh = Ag[g] * in_h + Hg[g]; op = in_p * Ag[g]; }
                ch_ = shx(oh, lane, 32); cp_ = shx(op, lane, 32);
#pragma unroll
                for (int i = 0; i < 4; ++i) { const int rI = 4 * g + i;
                    ((LAS unsigned*)scr)[crow(rI, hi) * SCR_STRIDE + 32 * nbk + tok] = pk2(hl_[rI] + pl_[rI] * in_h, in_p * pl_[rI]); }
            }
            if (hi) { v.aggA[(size_t)bc * 512 + ch] = op; v.aggH[(size_t)bc * 512 + ch] = oh; }
        }
        asm volatile("s_waitcnt lgkmcnt(0)" ::: "memory");
#pragma unroll
        for (int j = 0; j < 4; ++j) { const int tk = 8 * j + (lane >> 3), c8 = (lane & 7) * 8;
            const u32x4 w0 = *(const LAS u32x4*)(scr + tk * SCR_STRIDE + c8), w1 = *(const LAS u32x4*)(scr + tk * SCR_STRIDE + c8 + 4);
            u32x4 hv, pv;
            hv.x = (w0.x & 0xffffu) | (w0.y << 16); hv.y = (w0.z & 0xffffu) | (w0.w << 16); hv.z = (w1.x & 0xffffu) | (w1.y << 16); hv.w = (w1.z & 0xffffu) | (w1.w << 16);
            pv.x = (w0.x >> 16) | (w0.y & 0xffff0000u); pv.y = (w0.z >> 16) | (w0.w & 0xffff0000u); pv.z = (w1.x >> 16) | (w1.y & 0xffff0000u); pv.w = (w1.z >> 16) | (w1.w & 0xffff0000u);
            const size_t o = (size_t)(t0 + tk) * 512 + h * 64 + c8;
            *(u32x4*)(v.hl + o) = hv; *(u32x4*)(v.pc + o) = pv; }
        asm volatile("s_waitcnt lgkmcnt(0)" ::: "memory");
    }
}
}

namespace mrg {
__device__ __forceinline__ void phase(const Ctx& c0) {
    const Ctx c = fresh(c0); const LV v = make_lv(c);
    const int lane = c.lane, w = c.wave;
    LAS float* cl = (LAS float*)c.lds;
    f32x4 gl0, gl1, ga0, ga1;
    { const float* gl = inp(c, 12) + c.l * 512 + lane * 8; const float* ga = inp(c, 13) + c.l * 512 + lane * 8; gl0 = *(const f32x4*)gl; gl1 = *(const f32x4*)(gl + 4); ga0 = *(const f32x4*)ga; ga1 = *(const f32x4*)(ga + 4); }
    for (int item = c.bid; item < T / 128; item += c.G) {
        const int b = item >> 5, chunk0 = (item & 31) * 4;
        struct MB { u32x4 hl[2], pc[2], gg[2]; u32x2 o0[2], o1[2], o2[2]; float l0[2], l1[2], l2[2]; };
#define MRG_LOAD(B_, ib_) do { _Pragma("unroll") for (int q = 0; q < 2; ++q) { const size_t t = (size_t)item * 128 + w * 16 + (ib_) + q, o = t * 512 + lane * 8; \
                B_.hl[q] = __builtin_nontemporal_load((const u32x4*)(v.hl + o)); B_.pc[q] = __builtin_nontemporal_load((const u32x4*)(v.pc + o)); B_.gg[q] = __builtin_nontemporal_load((const u32x4*)(v.gg + o)); \
                B_.o0[q] = __builtin_nontemporal_load((const u32x2*)((const unsigned char*)v.obr + o)); B_.o1[q] = __builtin_nontemporal_load((const u32x2*)((const unsigned char*)v.obr + (size_t)T * 512 + o)); B_.o2[q] = __builtin_nontemporal_load((const u32x2*)((const unsigned char*)v.obr + (size_t)2 * T * 512 + o)); \
                B_.l0[q] = v.lbr[t * 8 + (lane >> 3)]; B_.l1[q] = v.lbr[(size_t)T * 8 + t * 8 + (lane >> 3)]; B_.l2[q] = v.lbr[(size_t)2 * T * 8 + t * 8 + (lane >> 3)]; } } while (0)
        MB cur, nxt;
        MRG_LOAD(cur, 0);
        __syncthreads();
        { const float* A0 = v.aggA + (size_t)b * NCHUNK * 512; const float* H0 = v.aggH + (size_t)b * NCHUNK * 512;
          LAS float* part = cl + 4 * 512;
          const int seg = (chunk0 + 7) >> 3, k0 = w * seg, k1 = min(k0 + seg, chunk0);
          float pa[8], ph[8];
#pragma unroll
          for (int j = 0; j < 8; ++j) { pa[j] = 1.f; ph[j] = 0.f; }
          for (int k = k0; k < k1; k += 6) { float a[6][8], h[6][8];
#pragma unroll
              for (int q = 0; q < 6; ++q) { const int kk = min(k + q, k1 - 1);
#pragma unroll
                  for (int j = 0; j < 8; ++j) { a[q][j] = A0[(size_t)kk * 512 + lane + 64 * j]; h[q][j] = H0[(size_t)kk * 512 + lane + 64 * j]; } }
#pragma unroll
              for (int q = 0; q < 6; ++q) if (k + q < k1) {
#pragma unroll
                  for (int j = 0; j < 8; ++j) { ph[j] = a[q][j] * ph[j] + h[q][j]; pa[j] *= a[q][j]; } } }
#pragma unroll
          for (int j = 0; j < 8; ++j) { part[(w * 512 + lane + 64 * j) * 2] = pa[j]; part[(w * 512 + lane + 64 * j) * 2 + 1] = ph[j]; }
          __syncthreads();
          float hc = 0.f;
#pragma unroll
          for (int q = 0; q < 8; ++q) hc = part[(q * 512 + c.tid) * 2] * hc + part[(q * 512 + c.tid) * 2 + 1];
          const float* A = A0 + c.tid; const float* H = H0 + c.tid;
          float a4[4], h4[4];
#pragma unroll
          for (int j = 0; j < 4; ++j) { a4[j] = A[(chunk0 + j) * 512]; h4[j] = H[(chunk0 + j) * 512]; }
#pragma unroll
          for (int j = 0; j < 4; ++j) { cl[j * 512 + c.tid] = hc; hc = a4[j] * hc + h4[j]; } }
        __syncthreads();
        const LAS float* cr = cl + (w >> 1) * 512 + lane * 8;
        const f32x4 c0v = *(const LAS f32x4*)cr, c1v = *(const LAS f32x4*)(cr + 4);
        const float cv[8] = {c0v[0], c0v[1], c0v[2], c0v[3], c1v[0], c1v[1], c1v[2], c1v[3]};
        for (int ib = 0; ib < 16; ib += 2) {
            if (ib + 2 < 16) MRG_LOAD(nxt, ib + 2);
#pragma unroll
            for (int q = 0; q < 2; ++q) { const size_t t = (size_t)item * 128 + w * 16 + ib + q;
                const u32x4 hlq = cur.hl[q], pcq = cur.pc[q], ggq = cur.gg[q]; const u32x2 o0q = cur.o0[q], o1q = cur.o1[q], o2q = cur.o2[q]; const float l0q = cur.l0[q], l1q = cur.l1[q], l2q = cur.l2[q];
                const float rden = frcp(l0q + l1q + l2q) * (1.f / attn::OBR_SCALE);
                float b0[8], b1[8], b2[8];
#pragma unroll
                for (int e = 0; e < 2; ++e) {
                    const auto p0l = __builtin_amdgcn_cvt_pk_f32_fp8((int)o0q[e], false), p0h = __builtin_amdgcn_cvt_pk_f32_fp8((int)o0q[e], true);
                    const auto p1l = __builtin_amdgcn_cvt_pk_f32_fp8((int)o1q[e], false), p1h = __builtin_amdgcn_cvt_pk_f32_fp8((int)o1q[e], true);
                    const auto p2l = __builtin_amdgcn_cvt_pk_f32_fp8((int)o2q[e], false), p2h = __builtin_amdgcn_cvt_pk_f32_fp8((int)o2q[e], true);
                    b0[4 * e] = p0l[0]; b0[4 * e + 1] = p0l[1]; b0[4 * e + 2] = p0h[0]; b0[4 * e + 3] = p0h[1];
                    b1[4 * e] = p1l[0]; b1[4 * e + 1] = p1l[1]; b1[4 * e + 2] = p1h[0]; b1[4 * e + 3] = p1h[1];
                    b2[4 * e] = p2l[0]; b2[4 * e + 1] = p2l[1]; b2[4 * e + 2] = p2h[0]; b2[4 * e + 3] = p2h[1]; }
                float yl[8], ya[8]; float s1 = 0.f, s2 = 0.f;
#pragma unroll
                for (int j = 0; j < 8; ++j) { const unsigned sh = (j & 1) * 16;
                    const float hv = bf2f((hlq[j >> 1] >> sh) & 0xffffu) + bf2f((pcq[j >> 1] >> sh) & 0xffffu) * cv[j];
                    yl[j] = hv * bf2f((ggq[j >> 1] >> sh) & 0xffffu); s1 += yl[j] * yl[j];
                    ya[j] = (l0q * b0[j] + l1q * b1[j] + l2q * b2[j]) * rden; s2 += ya[j] * ya[j]; }
                s1 = wave_sum(s1, lane); s2 = wave_sum(s2, lane);
                const float r1 = frsq(s1 * (1.f / 512.f) + EPS), r2 = frsq(s2 * (1.f / 512.f) + EPS);
                u32x4 m0, m1;
                m0.x = pk2(yl[0] * r1 * gl0[0], yl[1] * r1 * gl0[1]); m0.y = pk2(yl[2] * r1 * gl0[2], yl[3] * r1 * gl0[3]); m0.z = pk2(yl[4] * r1 * gl1[0], yl[5] * r1 * gl1[1]); m0.w = pk2(yl[6] * r1 * gl1[2], yl[7] * r1 * gl1[3]);
                m1.x = pk2(ya[0] * r2 * ga0[0], ya[1] * r2 * ga0[1]); m1.y = pk2(ya[2] * r2 * ga0[2], ya[3] * r2 * ga0[3]); m1.z = pk2(ya[4] * r2 * ga1[0], ya[5] * r2 * ga1[1]); m1.w = pk2(ya[6] * r2 * ga1[2], ya[7] * r2 * ga1[3]);
                *(u32x4*)(v.merged + t * 1024 + lane * 8) = m0; *(u32x4*)(v.merged + t * 1024 + 512 + lane * 8) = m1;
            }
            cur = nxt;
        }
    }
}
}

namespace rtr {
constexpr int WROW = 1040, L_W = 0, L_LG = 96 * WROW, L_CNT = L_LG + 8 * 16 * 48 * 4, L_BASE = L_CNT + 128, L_BIAS = L_BASE + 128;
static_assert(L_BIAS + 160 <= LDS_MISC, "router LDS map");
__device__ __forceinline__ void phase(const Ctx& c0, bool dry = false) {
    const Ctx c = fresh(c0); LV v = make_lv(c);
    if (dry) { v.counts = (unsigned*)(c.ws + WS_CTL) + 2048; v.list = (int*)v.tmp; v.asg_e = (int*)v.tmp + 32 * T; v.asg_pos = v.asg_e + 2 * T; v.asg_w = (float*)(v.asg_pos + 2 * T); v.rstd2 = v.asg_w + 2 * T; v.rsl = (float*)v.tmp + 40 * T; }
    const int lane = c.lane, r16 = lane & 15, q4 = lane >> 4;
    { LAS float* bl = (LAS float*)(c.lds + L_BIAS);
      if (c.tid < 32) bl[c.tid] = (inp(c, 19) + c.l * 32)[c.tid]; else if (c.tid < 36) bl[c.tid] = (inp(c, 17) + c.l * 4)[c.tid - 32]; }
    const LAS float* be = (const LAS float*)(c.lds + L_BIAS); const LAS float* bg = be + 32;
    LAS float* lg = (LAS float*)(c.lds + L_LG) + c.wave * 16 * 48;
    LAS unsigned* cnt = (LAS unsigned*)(c.lds + L_CNT); LAS unsigned* base = (LAS unsigned*)(c.lds + L_BASE);
    const int npass = (T / 16 + c.NGW - 1) / c.NGW;
    for (int ps = 0; ps < npass; ++ps) {
        const int it = ps * c.NGW + c.gw; const bool act = it < T / 16;
        const bf16* xr = v.xb + (size_t)((act ? it : 0) * 16 + r16) * 1024 + 8 * q4;
        f32x4 acc[3] = {{0.f, 0.f, 0.f, 0.f}, {0.f, 0.f, 0.f, 0.f}, {0.f, 0.f, 0.f, 0.f}}; float ss = 0.f;
        u32x4 xa[4], xn[4];
#pragma unroll
        for (int i = 0; i < 4; ++i) xa[i] = *(const u32x4*)(xr + 32 * i);
        for (int half = 0; half < 2; ++half) {
            __syncthreads();
            if (half == 0 && c.tid < 32) cnt[c.tid] = 0u;
#pragma unroll
            for (int j = 0; j < 12; ++j) { const int p = c.tid + 512 * j, rr = p >> 6, o16 = p & 63;
                *(LAS u32x4*)(c.lds + L_W + rr * WROW + o16 * 16) = *(const u32x4*)(v.wr + (size_t)rr * 1024 + half * 512 + o16 * 8); }
            __syncthreads();
            for (int g = 0; g < 4; ++g) {
                const int en = half * 512 + (g + 1) * 128;
                if (en < 1024) {
#pragma unroll
                    for (int i = 0; i < 4; ++i) xn[i] = *(const u32x4*)(xr + en + 32 * i); }
#pragma unroll
                for (int i = 0; i < 4; ++i) { const int k0 = g * 128 + 32 * i;
                    const u32x4 xw = xa[i];
                    const bf16x8 ahi = __builtin_bit_cast(bf16x8, xw);
#pragma unroll
                    for (int j = 0; j < 4; ++j) { const float a = bf2f(xw[j] & 0xffffu), b = bf2f(xw[j] >> 16); ss += a * a + b * b; }
#pragma unroll
                    for (int cb = 0; cb < 3; ++cb) { const LAS unsigned char* wp = c.lds + L_W + (cb * 16 + r16) * WROW + (k0 + 8 * q4) * 2;
                        const bf16x8 bh = *(const LAS bf16x8*)wp, bl = *(const LAS bf16x8*)(wp + 48 * WROW);
                        acc[cb] = __builtin_amdgcn_mfma_f32_16x16x32_bf16(ahi, bh, acc[cb], 0, 0, 0);
                        acc[cb] = __builtin_amdgcn_mfma_f32_16x16x32_bf16(ahi, bl, acc[cb], 0, 0, 0); }
                }
#pragma unroll
                for (int i = 0; i < 4; ++i) xa[i] = xn[i];
            }
        }
        int ea = 0, eb = 0, la = 0, lb = 0; float w1 = 0.f, w2 = 0.f, rs_keep = 0.f;
        if (act) {
            ss += shx(ss, lane, 16); ss += shx(ss, lane, 32);
            const float rs = frsq(ss * (1.f / 1024.f) + EPS); rs_keep = rs;
#pragma unroll
            for (int reg = 0; reg < 4; ++reg) { const float rsr = __builtin_bit_cast(float, __builtin_amdgcn_ds_bpermute((4 * q4 + reg) << 2, __builtin_bit_cast(int, rs)));
#pragma unroll
                for (int cb = 0; cb < 3; ++cb) lg[(4 * q4 + reg) * 48 + cb * 16 + r16] = acc[cb][reg] * rsr; }
            asm volatile("s_waitcnt lgkmcnt(0)" ::: "memory");
            if (lane < 16) {
                const int t = it * 16 + lane; const LAS float* L = lg + lane * 48;
                v.rstd2[t] = rs;
                float gl4[4];
#pragma unroll
                for (int j = 0; j < 4; ++j) gl4[j] = L[32 + j] + bg[j];
                int g = 0; float gm = gl4[0];
#pragma unroll
                for (int j = 1; j < 4; ++j) if (gl4[j] > gm) { gm = gl4[j]; g = j; }
                float den = 0.f;
#pragma unroll
                for (int j = 0; j < 4; ++j) den += __expf(gl4[j] - gm);
                const float ptop = 1.f / den;
                int i1 = 0; float v1 = L[g * 8] + be[g * 8];
                for (int j = 1; j < 8; ++j) { const float x = L[g * 8 + j] + be[g * 8 + j]; if (x > v1) { v1 = x; i1 = j; } }
                int i2 = -1; float v2 = -INFINITY;
                for (int j = 0; j < 8; ++j) { const float x = L[g * 8 + j] + be[g * 8 + j]; if (j != i1 && x > v2) { v2 = x; i2 = j; } }
                const float e2 = __expf(v2 - v1); w1 = ptop / (1.f + e2); w2 = ptop * e2 / (1.f + e2);
                ea = g * 8 + i1; eb = g * 8 + i2;
                la = (int)atomicAdd((unsigned*)(cnt + ea), 1u); lb = (int)atomicAdd((unsigned*)(cnt + eb), 1u);
            }
        }
        __syncthreads();
        if (c.tid < 32) { const unsigned n = cnt[c.tid]; base[c.tid] = n ? atomicAdd(&v.counts[c.tid], n) : 0u; }
        __syncthreads();
        if (act && lane < 16) {
            const int t = it * 16 + lane; const int pa = (int)base[ea] + la, pb = (int)base[eb] + lb;
            v.asg_e[2 * t] = ea; v.asg_pos[2 * t] = pa; v.asg_w[2 * t] = w1; v.list[(size_t)ea * T + pa] = 2 * t; v.rsl[(size_t)ea * T + pa] = rs_keep;
            v.asg_e[2 * t + 1] = eb; v.asg_pos[2 * t + 1] = pb; v.asg_w[2 * t + 1] = w2; v.list[(size_t)eb * T + pb] = 2 * t + 1; v.rsl[(size_t)eb * T + pb] = rs_keep;
        }
    }
}
}

namespace cmb {
__device__ __forceinline__ void phase(const Ctx& c0, bool dry = false) {
    const Ctx c = fresh(c0); const LV v = make_lv(c);
    LAS int* tstart = moe_plan_reuse(c); const int lane = c.lane;
    bf16* xbo = dry ? (bf16*)v.tmp : v.xb; float* ro = dry ? v.rstd2 : v.rstd1; const bool last = (c.l == DEPTH - 1) && !dry;
    constexpr int NBT = 4;
    const unsigned char* ys8 = (const unsigned char*)v.ys;
    struct Asg { int ae[NBT][2], ap[NBT][2]; float aw[NBT][2]; };
    struct Buf { u32x4 xw[NBT][2], y0[NBT], y1[NBT]; float g0[NBT], g1[NBT]; };
#define CMB_ASG(A_, tb) do { _Pragma("unroll") for (int q = 0; q < NBT; ++q) { const int t_ = min((tb) + q * c.NGW, T - 1); \
        A_.ae[q][0] = v.asg_e[2 * t_]; A_.ae[q][1] = v.asg_e[2 * t_ + 1]; A_.ap[q][0] = v.asg_pos[2 * t_]; A_.ap[q][1] = v.asg_pos[2 * t_ + 1]; A_.aw[q][0] = v.asg_w[2 * t_]; A_.aw[q][1] = v.asg_w[2 * t_ + 1]; } } while (0)
#define CMB_LOAD(B_, A_, tb) do { _Pragma("unroll") for (int q = 0; q < NBT; ++q) { const int t = min((tb) + q * c.NGW, T - 1); \
        const size_t r0 = (size_t)tstart[A_.ae[q][0]] * 256 + A_.ap[q][0], r1 = (size_t)tstart[A_.ae[q][1]] * 256 + A_.ap[q][1]; B_.g0[q] = A_.aw[q][0] * (1.f / pg8::YS_SCALE); B_.g1[q] = A_.aw[q][1] * (1.f / pg8::YS_SCALE); \
        B_.xw[q][0] = *(const u32x4*)(v.xb + (size_t)t * 1024 + lane * 16); B_.xw[q][1] = *(const u32x4*)(v.xb + (size_t)t * 1024 + lane * 16 + 8); \
        B_.y0[q] = __builtin_nontemporal_load((const u32x4*)(ys8 + r0 * 1024 + lane * 16)); B_.y1[q] = __builtin_nontemporal_load((const u32x4*)(ys8 + r1 * 1024 + lane * 16)); } } while (0)
    const int step = NBT * c.NGW;
    Asg an; Buf cur, nxt;
    CMB_ASG(an, c.gw);
    if (c.gw < T) CMB_LOAD(cur, an, c.gw);
    if (c.gw + step < T) CMB_ASG(an, c.gw + step);
    for (int tb = c.gw; tb < T; tb += step) {
        if (tb + step < T) CMB_LOAD(nxt, an, tb + step);
        if (tb + 2 * step < T) CMB_ASG(an, tb + 2 * step);
#pragma unroll
        for (int q = 0; q < NBT; ++q) { const int t = tb + q * c.NGW; if (t >= T) break;
            float xv[16];
#pragma unroll
            for (int e = 0; e < 4; ++e) {
                const auto a_lo = __builtin_amdgcn_cvt_pk_f32_fp8((int)cur.y0[q][e], false), a_hi = __builtin_amdgcn_cvt_pk_f32_fp8((int)cur.y0[q][e], true);
                const auto b_lo = __builtin_amdgcn_cvt_pk_f32_fp8((int)cur.y1[q][e], false), b_hi = __builtin_amdgcn_cvt_pk_f32_fp8((int)cur.y1[q][e], true);
                const unsigned xa = cur.xw[q][e >> 1][(e & 1) * 2], xb2 = cur.xw[q][e >> 1][(e & 1) * 2 + 1];
                xv[4 * e + 0] = bf2f(xa & 0xffffu) + cur.g0[q] * a_lo[0] + cur.g1[q] * b_lo[0]; xv[4 * e + 1] = bf2f(xa >> 16) + cur.g0[q] * a_lo[1] + cur.g1[q] * b_lo[1];
                xv[4 * e + 2] = bf2f(xb2 & 0xffffu) + cur.g0[q] * a_hi[0] + cur.g1[q] * b_hi[0]; xv[4 * e + 3] = bf2f(xb2 >> 16) + cur.g0[q] * a_hi[1] + cur.g1[q] * b_hi[1]; }
            const size_t i = (size_t)t * 1024 + lane * 16;
            if (last) {
#pragma unroll
                for (int e = 0; e < 4; ++e) *(f32x4*)(v.x + i + 4 * e) = (f32x4){xv[4 * e], xv[4 * e + 1], xv[4 * e + 2], xv[4 * e + 3]}; }
            else { u32x4 w0, w1; w0.x = pk2(xv[0], xv[1]); w0.y = pk2(xv[2], xv[3]); w0.z = pk2(xv[4], xv[5]); w0.w = pk2(xv[6], xv[7]);
                w1.x = pk2(xv[8], xv[9]); w1.y = pk2(xv[10], xv[11]); w1.z = pk2(xv[12], xv[13]); w1.w = pk2(xv[14], xv[15]);
                *(u32x4*)(xbo + i) = w0; *(u32x4*)(xbo + i + 8) = w1; }
            float s2 = 0.f;
#pragma unroll
            for (int e = 0; e < 16; ++e) s2 += xv[e] * xv[e];
            s2 = wave_sum(s2, lane);
            if (lane == 0) ro[t] = frsq(s2 * (1.f / 1024.f) + EPS);
        }
        cur = nxt;
    }
#undef CMB_LOAD
#undef CMB_ASG
}
}

#ifndef REP_C2
#define REP_C2 1
#endif
#ifndef REP_RTR
#define REP_RTR 1
#endif
#ifndef REP_CMB
#define REP_CMB 1
#endif
#ifndef REP_P0
#define REP_P0 1
#endif
#ifndef REP_A
#define REP_A 1
#endif
#ifndef REP_ATT
#define REP_ATT 1
#endif
#ifndef REP_LRU
#define REP_LRU 1
#endif
#ifndef REP_MRG
#define REP_MRG 1
#endif
#ifndef REP_E1
#define REP_E1 1
#endif
#ifndef REP_E2
#define REP_E2 1
#endif
#ifndef OPT_LRU
#define OPT_LRU 1
#endif
#ifndef OPT_MRG
#define OPT_MRG 1
#endif
#ifndef OPT_RTR
#define OPT_RTR 1
#endif
#ifndef OPT_CMB
#define OPT_CMB 1
#endif
#ifndef OPT_B
#define OPT_B 1
#endif
#ifndef OPT_A
#define OPT_A 1
#endif
#ifndef OPT_C2
#define OPT_C2 1
#endif
#ifndef OPT_E1
#define OPT_E1 1
#endif
#ifndef OPT_E2
#define OPT_E2 1
#endif

namespace cg = cooperative_groups;
struct Args { Params p; int coop; int pad; };
__global__ void __launch_bounds__(NTHREADS, 2) mega(Args a) {
    extern __shared__ __attribute__((aligned(16))) unsigned char lds_raw[];
    Ctx c; c.ws = a.p.ws; c.out = a.p.out; c.lds = (LAS unsigned char*)lds_raw;
    c.tid = threadIdx.x; c.lane = c.tid & 63; c.wave = __builtin_amdgcn_readfirstlane(c.tid >> 6);
    c.G = gridDim.x; c.bid = blockIdx.x; c.gw = c.bid * NWAVES + c.wave; c.NGW = c.G * NWAVES; c.gt = c.bid * NTHREADS + c.tid; c.NGT = c.G * NTHREADS; c.l = 0;
    volatile LAS unsigned* misc = (volatile LAS unsigned*)(c.lds + LDS_MISC + 512);
    if (c.tid < 2) misc[c.tid] = 0u;
    if (c.tid == 0) { LAS unsigned long long* tab = (LAS unsigned long long*)(c.lds + LDS_TAB);
#pragma unroll
        for (int i = 0; i < 23; ++i) tab[i] = (unsigned long long)a.p.in[i]; }
    __syncthreads();
    (void)xcd_barrier_post((unsigned*)(c.ws + WS_CTL) + CW_BAR, misc);
#define GRID_BAR() do { const Ctx f_ = fresh(c); XcdBarrier b_; b_.bar = (unsigned*)(f_.ws + WS_CTL) + CW_BAR; b_.x = xb_xcc_id(); b_.st = (volatile LAS unsigned*)(f_.lds + LDS_MISC + 512); xcd_barrier(b_); } while (0)
    for (int rep = 0; rep < REP_P0; ++rep) p0_prologue(c);
    GRID_BAR();
    for (int l = 0; l < DEPTH; ++l) {
        c.l = l;
        if (OPT_A) { for (int rep = 0; rep < REP_A; ++rep) { const Ctx f = fresh(c); const LV v = make_lv(f); pg8::DenseSched S{(const char*)v.xb, (const char*)v.win, T / 256, DIN / 256, D, f.G, f.bid};
            if (CV_AHEAD && f.l == 0 && rep == 0 && !(f.bid & 4)) { convert_items(f, 0, CV_WIN + CV_WOUT, CV_LAYER, f.gw, f.NGW); __syncthreads(); }
            pg8::gemm_phase(f.lds, S, pg8::EpiProj{v.rstd1, v.xl, inp(f, 10) + f.l * 64, inp(f, 11) + f.l * 64});
            if (CV_AHEAD && f.l == 0 && rep == 0 && (f.bid & 4)) { __syncthreads(); convert_items(f, 0, CV_WIN + CV_WOUT, CV_LAYER, f.gw, f.NGW); } } GRID_BAR(); }
        else { { const Ctx f = fresh(c); const LV v = make_lv(f); n_gemm(f, v.xb, v.win, T, DIN, D, EpiProjN{v.rstd1, v.xl, v.gg, v.v, v.tmp}); } GRID_BAR();
            n_qknorm(c); GRID_BAR(); }
        if (0 && OPT_B && OPT_LRU && REP_ATT == 1 && REP_LRU == 1) { if (c.bid & 8) { lru::phase(c); __syncthreads(); attn::phase(c); } else { attn::phase(c); lru::phase(c); } GRID_BAR(); }
        else {
        if (OPT_B) { for (int rep = 0; rep < REP_ATT; ++rep) attn::phase(c); } else n_attn(c);
        if (OPT_LRU) { for (int rep = 0; rep < REP_LRU; ++rep) lru::phase(c); GRID_BAR(); } }
        if (!OPT_LRU) { n_lru_au(c); GRID_BAR(); n_lru_scan(c); GRID_BAR(); }
        if (OPT_MRG) { for (int rep = 0; rep < REP_MRG; ++rep) mrg::phase(c); GRID_BAR(); }
        else { n_lru_carry(c); GRID_BAR(); n_merge(c); GRID_BAR(); }
        if (OPT_C2 && REP_C2 > 1) { const Ctx f = fresh(c); const LV v = make_lv(f); pg8::DenseSched S{(const char*)v.merged, (const char*)v.wout, T / 256, D / 256, D, f.G, f.bid}; pg8::gemm_phase(f.lds, S, pg8::EpiOut{v.xb, (bf16*)v.tmp}); }
        if (OPT_C2) { const Ctx f = fresh(c); const LV v = make_lv(f); pg8::DenseSched S{(const char*)v.merged, (const char*)v.wout, T / 256, D / 256, D, f.G, f.bid}; pg8::gemm_phase(f.lds, S, pg8::EpiOut{v.xb, v.xb}); }
        else { const Ctx f = fresh(c); const LV v = make_lv(f); n_gemm(f, v.merged, v.wout, T, D, D, EpiOutN{v.x, v.xb}); }
        GRID_BAR();
        if (OPT_RTR) { if (REP_RTR > 1) rtr::phase(c, true); rtr::phase(c); } else n_router(c);
        GRID_BAR();
        if (OPT_E1) for (int rep = 0; rep < REP_E1; ++rep) { const Ctx f = fresh(c); const LV v = make_lv(f); LAS int* ts = moe_plan(f, v.counts); pg8::MoeSched<true> S{(const char*)v.xb, (const char*)v.wgu, v.list, v.counts, ts, 1024, f.G, f.bid, (LAS int*)(f.lds + pg8::LDS_UTAB), (LAS int*)(f.lds + pg8::LDS_TOKTAB)}; S.fill_cache(f.tid); pg8::gemm_phase(f.lds, S, pg8::EpiUp{v.rsl, v.hid}); if (rep == 0) convert_ahead(f, 0, __builtin_amdgcn_readfirstlane(ts[NE]) * 4); }
        else n_moe_up(c);
        GRID_BAR();
        if (OPT_E2) for (int rep = 0; rep < REP_E2; ++rep) { const Ctx f = fresh(c); const LV v = make_lv(f); LAS int* ts = OPT_E1 ? moe_plan_reuse(f) : moe_plan(f, v.counts); pg8::MoeSched<false> S{(const char*)v.hid, (const char*)v.wd, v.list, v.counts, ts, 512, f.G, f.bid, (LAS int*)(f.lds + pg8::LDS_UTAB), (LAS int*)(f.lds + pg8::LDS_TOKTAB)}; if (!OPT_E1) S.fill_cache(f.tid); pg8::gemm_phase(f.lds, S, pg8::EpiDown{(unsigned char*)v.ys}); if (rep == 0) convert_ahead(f, 1, __builtin_amdgcn_readfirstlane(ts[NE]) * 4); }
        else n_moe_down(c);
        GRID_BAR();
        if (OPT_CMB) { if (REP_CMB > 1) cmb::phase(c, true); cmb::phase(c); } else n_combine(c);
        if (l + 1 < DEPTH) GRID_BAR();
    }
}

extern "C" void kernel_launch(void* const* d_in, const int* in_sizes, int n_in, void* d_out, int out_size, void* d_ws, size_t ws_size, hipStream_t stream) {
    static int grid = 0;
    if (grid == 0) {
        if (n_in != 23 || ws_size < WS_END) { fprintf(stderr, "kernel_launch: unexpected n_in %d or ws_size %zu (< %zu)\n", n_in, ws_size, (size_t)WS_END); grid = -1; return; }
        int dev = 0, cus = 0, per_cu = 0;
        (void)hipGetDevice(&dev); (void)hipDeviceGetAttribute(&cus, hipDeviceAttributeMultiprocessorCount, dev);
        (void)hipFuncSetAttribute((const void*)mega, hipFuncAttributeMaxDynamicSharedMemorySize, LDS_BYTES);
        (void)hipOccupancyMaxActiveBlocksPerMultiprocessor(&per_cu, (const void*)mega, NTHREADS, LDS_BYTES);
        if (per_cu < 1) { fprintf(stderr, "kernel_launch: occupancy query says %d blocks per CU\n", per_cu); per_cu = 1; }
        grid = cus * 1;
        fprintf(stderr, "kernel_launch: cus %d, per_cu %d, grid %d\n", cus, per_cu, grid);
    }
    if (grid < 0) return;
    (void)hipMemsetAsync((unsigned char*)d_ws + WS_CTL, 0, CTL_BYTES, stream);
    Args a{};
    for (int i = 0; i < 23; ++i) a.p.in[i] = (const float*)d_in[i];
    a.p.out = (float*)d_out; a.p.ws = (unsigned char*)d_ws; a.coop = 1; a.pad = 0;
    void* args[] = {&a};
    hipError_t e = hipLaunchCooperativeKernel((const void*)mega, dim3(grid), dim3(NTHREADS), args, LDS_BYTES, stream);
    if (e != hipSuccess) fprintf(stderr, "cooperative launch failed: %s (grid %d)\n", hipGetErrorString(e), grid);
}
```
